# Optimizing an MI355X kernel written in HIP

```python
import math
import jax, jax.numpy as jnp
from jax import lax
import numpy as np

D_MODEL = 4096
BATCH = 4
SEQ = 2048
DEPTH = 2
DEC_BATCH = 128
DEC_SEQ = 8
PAST_LEN = 16384
PAGE_SIZE = 128

W_A = D_MODEL // 4
W_B = D_MODEL // 2
W_C = D_MODEL // 4
MIX = W_A + W_B + W_C
CONV_A = 3
CONV_B = 4
LRU_HEADS = 16
LRU_HD = W_B // LRU_HEADS
LRU_C = 8.0
S5_GROUP = 16
S5_G = W_C // S5_GROUP
S5_P = 64
EPS = 1e-6
SPLITS = (W_A, W_A, W_A, W_A, W_B, W_B, W_C, W_C)
IN_COLS = 4 * W_A + 2 * W_B + 2 * W_C

kernel_name = "hybrid_conv_rglru_s5_decoder_step"


def _split_cols(z):
    out = []
    start = 0
    for w in SPLITS:
        out.append(z[..., start:start + w])
        start += w
    return out


def _rmsnorm(x, g):
    xf = x.astype(jnp.float32)
    y = xf * lax.rsqrt(jnp.mean(xf * xf, axis=-1, keepdims=True) + EPS)
    return (y * g.astype(jnp.float32)).astype(x.dtype)


def _causal_dwconv(buf, v, w, b):
    k_width = w.shape[0]
    t_len = v.shape[1]
    padded = jnp.concatenate([buf.astype(v.dtype), v], axis=1)
    y = b + sum(w[k] * padded[:, k:k + t_len] for k in range(k_width))
    return y, padded[:, t_len:]


def _real_combine(e1, e2):
    a1, b1 = e1
    a2, b2 = e2
    return a1 * a2, a2 * b1 + b2


def _complex_combine(e1, e2):
    ar1, ai1, br1, bi1 = e1
    ar2, ai2, br2, bi2 = e2
    return (ar2 * ar1 - ai2 * ai1,
            ar2 * ai1 + ai2 * ar1,
            ar2 * br1 - ai2 * bi1 + br2,
            ar2 * bi1 + ai2 * br1 + bi2)


def _layer(x, c, conv_a, conv_b, lru_h, s5_re, s5_im,
           g_norm, w_ada, b_ada, w_in, w_conv_a, b_conv_a, w_conv_b, b_conv_b,
           w_rg, b_rg, w_ig, b_ig, lru_lambda, s5_lambda_re, s5_lambda_im, s5_log_dt,
           s5_b_re, s5_b_im, s5_c_re, s5_c_im, s5_d, w_glu, b_glu, w_out):
    f32 = jnp.float32
    bn, t_len, _ = x.shape
    mod = c @ w_ada + b_ada
    shift, scale, gate = jnp.split(mod, 3, axis=-1)
    h = _rmsnorm(x, g_norm) * (1.0 + scale[:, None]) + shift[:, None]
    proj = h @ w_in
    a_b, a_c, a_x, a_g, b_x, b_g, c_u, c_g = _split_cols(proj)

    conv_in = a_c * a_x
    conv_out, conv_a_new = _causal_dwconv(conv_a, conv_in, w_conv_a, b_conv_a)
    out_a = a_b * conv_out * jax.nn.silu(a_g)

    xb, conv_b_new = _causal_dwconv(conv_b, b_x, w_conv_b, b_conv_b)
    xh = xb.reshape(bn, t_len, LRU_HEADS, LRU_HD)
    r = jax.nn.sigmoid(jnp.einsum('bthi,hij->bthj', xh, w_rg) + b_rg).reshape(bn, t_len, W_B)
    ig = jax.nn.sigmoid(jnp.einsum('bthi,hij->bthj', xh, w_ig) + b_ig).reshape(bn, t_len, W_B)
    log_a = -LRU_C * r.astype(f32) * jax.nn.softplus(-lru_lambda.astype(f32))
    a = jnp.exp(log_a)
    beta = jnp.sqrt(-jnp.expm1(2.0 * log_a))
    bt = beta * ig.astype(f32) * xb.astype(f32)
    bt = bt.at[:, 0].add(a[:, 0] * lru_h.astype(f32))
    _, hs = lax.associative_scan(_real_combine, (a, bt), axis=1)
    lru_h_new = hs[:, -1]
    out_b = hs.astype(x.dtype) * jax.nn.silu(b_g)

    dt = jnp.exp(s5_log_dt.astype(f32))[:, None]
    lre = s5_lambda_re.astype(f32)
    lim = s5_lambda_im.astype(f32)
    mag = jnp.exp(lre * dt)
    ab_re = mag * jnp.cos(lim * dt)
    ab_im = mag * jnp.sin(lim * dt)
    nr = ab_re - 1.0
    den = lre * lre + lim * lim
    fr = (nr * lre + ab_im * lim) / den
    fi = (ab_im * lre - nr * lim) / den
    bre = s5_b_re.astype(f32)
    bim = s5_b_im.astype(f32)
    bb_re = fr[..., None] * bre - fi[..., None] * bim
    bb_im = fr[..., None] * bim + fi[..., None] * bre
    u = c_u.reshape(bn, t_len, S5_G, S5_GROUP).astype(f32)
    bu_re = jnp.einsum('gpi,btgi->btgp', bb_re, u)
    bu_im = jnp.einsum('gpi,btgi->btgp', bb_im, u)
    h0r = s5_re.astype(f32)
    h0i = s5_im.astype(f32)
    bu_re = bu_re.at[:, 0].add(ab_re * h0r - ab_im * h0i)
    bu_im = bu_im.at[:, 0].add(ab_re * h0i + ab_im * h0r)
    ar = jnp.broadcast_to(ab_re, bu_re.shape)
    ai = jnp.broadcast_to(ab_im, bu_im.shape)
    _, _, hr, hi = lax.associative_scan(_complex_combine, (ar, ai, bu_re, bu_im), axis=1)
    s5_re_new = hr[:, -1]
    s5_im_new = hi[:, -1]
    y = (jnp.einsum('gip,btgp->btgi', s5_c_re.astype(f32), hr)
         - jnp.einsum('gip,btgp->btgi', s5_c_im.astype(f32), hi)
         + s5_d.astype(f32) * u).reshape(bn, t_len, W_C).astype(x.dtype)
    y = jax.nn.gelu(y)
    y = y * jax.nn.sigmoid(y @ w_glu + b_glu)
    out_c = y * jax.nn.silu(c_g)

    mixed = jnp.concatenate([out_a, out_b, out_c], axis=-1) @ w_out
    x = x + gate[:, None] * mixed
    return (x, conv_a_new, conv_b_new, lru_h_new.astype(x.dtype),
            s5_re_new.astype(x.dtype), s5_im_new.astype(x.dtype))


def setup_inputs(seed: int = 0) -> dict:
    key = jax.random.key(seed)
    ks = iter(jax.random.split(key, 40))
    f32 = jnp.float32
    nrm = lambda shape, s: jax.random.normal(next(ks), shape, f32) * s
    u_lru = jax.random.uniform(next(ks), (DEPTH, W_B), f32, 0.9, 0.999)
    log_dt = jax.random.uniform(next(ks), (DEPTH, S5_G), f32,
                                math.log(0.001), math.log(0.1))
    lam_im = jnp.broadcast_to(jnp.pi * jnp.arange(S5_P, dtype=f32), (DEPTH, S5_G, S5_P))
    return {
        "x_prompt": nrm((BATCH, SEQ, D_MODEL), 1.0),
        "x_sample": nrm((DEC_BATCH, DEC_SEQ, D_MODEL), 1.0),
        "c_prompt": nrm((BATCH, D_MODEL), 1.0),
        "c_sample": nrm((DEC_BATCH, D_MODEL), 1.0),
        "state_conv_a": nrm((DEPTH, DEC_BATCH, CONV_A - 1, W_A), 1.0),
        "state_conv_b": nrm((DEPTH, DEC_BATCH, CONV_B - 1, W_B), 1.0),
        "state_lru_h": nrm((DEPTH, DEC_BATCH, W_B), 0.5),
        "state_s5_re": nrm((DEPTH, DEC_BATCH, S5_G, S5_P), 0.5),
        "state_s5_im": nrm((DEPTH, DEC_BATCH, S5_G, S5_P), 0.5),
        "g_norm": 1.0 + nrm((DEPTH, D_MODEL), 0.02),
        "w_ada": nrm((DEPTH, D_MODEL, 3 * D_MODEL), 0.5 * D_MODEL ** -0.5),
        "b_ada": nrm((DEPTH, 3 * D_MODEL), 0.02),
        "w_in": nrm((DEPTH, D_MODEL, IN_COLS), D_MODEL ** -0.5),
        "w_conv_a": nrm((DEPTH, CONV_A, W_A), CONV_A ** -0.5),
        "b_conv_a": nrm((DEPTH, W_A), 0.02),
        "w_conv_b": nrm((DEPTH, CONV_B, W_B), CONV_B ** -0.5),
        "b_conv_b": nrm((DEPTH, W_B), 0.02),
        "w_rg": nrm((DEPTH, LRU_HEADS, LRU_HD, LRU_HD), LRU_HD ** -0.5),
        "b_rg": nrm((DEPTH, LRU_HEADS, LRU_HD), 0.02),
        "w_ig": nrm((DEPTH, LRU_HEADS, LRU_HD, LRU_HD), LRU_HD ** -0.5),
        "b_ig": nrm((DEPTH, LRU_HEADS, LRU_HD), 0.02),
        "lru_lambda": jnp.log(u_lru) - jnp.log1p(-u_lru),
        "s5_lambda_re": -0.5 + nrm((DEPTH, S5_G, S5_P), 0.01),
        "s5_lambda_im": lam_im + nrm((DEPTH, S5_G, S5_P), 0.01),
        "s5_log_dt": log_dt,
        "s5_b_re": nrm((DEPTH, S5_G, S5_P, S5_GROUP), (2.0 * S5_GROUP) ** -0.5),
        "s5_b_im": nrm((DEPTH, S5_G, S5_P, S5_GROUP), (2.0 * S5_GROUP) ** -0.5),
        "s5_c_re": nrm((DEPTH, S5_G, S5_GROUP, S5_P), (2.0 * S5_P) ** -0.5),
        "s5_c_im": nrm((DEPTH, S5_G, S5_GROUP, S5_P), (2.0 * S5_P) ** -0.5),
        "s5_d": nrm((DEPTH, S5_G, S5_GROUP), 1.0),
        "w_glu": nrm((DEPTH, W_C, W_C), W_C ** -0.5),
        "b_glu": nrm((DEPTH, W_C), 0.02),
        "w_out": nrm((DEPTH, MIX, D_MODEL), MIX ** -0.5),
        "g_final": 1.0 + nrm((D_MODEL,), 0.02),
    }


def reference(x_prompt, x_sample, c_prompt, c_sample,
              state_conv_a, state_conv_b, state_lru_h, state_s5_re, state_s5_im,
              g_norm, w_ada, b_ada, w_in, w_conv_a, b_conv_a, w_conv_b, b_conv_b,
              w_rg, b_rg, w_ig, b_ig, lru_lambda, s5_lambda_re, s5_lambda_im, s5_log_dt,
              s5_b_re, s5_b_im, s5_c_re, s5_c_im, s5_d, w_glu, b_glu, w_out, g_final):
    dt_p = x_prompt.dtype
    bp = x_prompt.shape[0]
    xp = x_prompt
    xs = x_sample
    p_ca, p_cb, p_h, p_re, p_im = [], [], [], [], []
    s_ca, s_cb, s_h, s_re, s_im = [], [], [], [], []
    for l in range(DEPTH):
        w_l = (g_norm[l], w_ada[l], b_ada[l], w_in[l], w_conv_a[l], b_conv_a[l],
               w_conv_b[l], b_conv_b[l], w_rg[l], b_rg[l], w_ig[l], b_ig[l],
               lru_lambda[l], s5_lambda_re[l], s5_lambda_im[l], s5_log_dt[l],
               s5_b_re[l], s5_b_im[l], s5_c_re[l], s5_c_im[l], s5_d[l],
               w_glu[l], b_glu[l], w_out[l])
        zp = (jnp.zeros((bp, CONV_A - 1, W_A), dt_p), jnp.zeros((bp, CONV_B - 1, W_B), dt_p),
              jnp.zeros((bp, W_B), dt_p), jnp.zeros((bp, S5_G, S5_P), dt_p),
              jnp.zeros((bp, S5_G, S5_P), dt_p))
        xp, ca, cb, hh, sr, si = _layer(xp, c_prompt, *zp, *w_l)
        p_ca.append(ca); p_cb.append(cb); p_h.append(hh); p_re.append(sr); p_im.append(si)
        xs, ca, cb, hh, sr, si = _layer(xs, c_sample, state_conv_a[l], state_conv_b[l],
                                        state_lru_h[l], state_s5_re[l], state_s5_im[l], *w_l)
        s_ca.append(ca); s_cb.append(cb); s_h.append(hh); s_re.append(sr); s_im.append(si)
    y_prompt = _rmsnorm(xp, g_final)
    y_sample = _rmsnorm(xs, g_final)
    return (y_prompt, y_sample,
            jnp.stack(p_ca), jnp.stack(p_cb), jnp.stack(p_h), jnp.stack(p_re), jnp.stack(p_im),
            jnp.stack(s_ca), jnp.stack(s_cb), jnp.stack(s_h), jnp.stack(s_re), jnp.stack(s_im))
```

```cpp
#include <hip/hip_runtime.h>
#include <cstdio>
#include <cstdint>
#include <hip/hip_runtime.h>
#include <cstdio>
#include <cstdint>
namespace pg8 {
#define PG8_LAS __attribute__((address_space(3)))
typedef unsigned short bf16_t;
typedef short bf16x8 __attribute__((ext_vector_type(8)));
typedef float f32x4 __attribute__((ext_vector_type(4)));
typedef unsigned u32x4 __attribute__((ext_vector_type(4)));
constexpr int BM = 256, BK = 64, HALF = 128, HTB = HALF * BK * 2  , STAGE_BYTES = 8 * HTB, NXCD = 8, WGM = 8;

__host__ __device__ __forceinline__ int lds_byte(int r, int c) { const int st = (r >> 4) * 2 + (c >> 5), rr = r & 15, cc = c & 31, ob = rr * 64 + cc * 2; return st * 1024 + (ob ^ (((ob >> 9) & 1) << 5)); }
__host__ __device__ __forceinline__ void stage_rc(int b, int& R, int& C) { const int st = b / 1024, sb = b % 1024, swz = sb ^ (((sb >> 9) & 1) << 5); R = (st >> 1) * 16 + swz / 64; C = (st & 1) * 32 + (swz % 64) / 2; }
__host__ __device__ __forceinline__ int perm32(int rho) { const int n = rho >> 4, i = rho & 15; return 8 * (i >> 2) + 4 * n + (i & 3); }

struct Unit { int pm, pn; };
struct Gemm { const bf16_t* A; const bf16_t* Bt; int M, N, K; };

struct StaticOrder {
    int nM, nN, nwg, G, c;
    __host__ __device__ void init(int M, int N, int G_, int c_) { nM = M / BM; nN = N / BM; nwg = nM * nN; G = G_; c = c_; }
    __host__ __device__ bool next(int i, Unit& u) const {
        const long L = (long)i * G + c; if (L >= nwg) return false;
        int wgid = (int)L; { const int q = nwg / NXCD, r = nwg % NXCD, xcd = wgid % NXCD, off = wgid / NXCD; wgid = (xcd < r ? xcd * (q + 1) : r * (q + 1) + (xcd - r) * q) + off; }
        const int nig = WGM * nN, gid = wgid / nig, fm = gid * WGM, gsz = (nM - fm) < WGM ? (nM - fm) : WGM;
        u.pm = fm + ((wgid % nig) % gsz); u.pn = (wgid % nig) / gsz; return true;
    }
    __device__ __forceinline__ void a_ready(const Unit&) const {}
    __device__ __forceinline__ void done(const Unit&) const {}
};

__device__ __forceinline__ unsigned cvt_pk_bf16(float lo, float hi) { unsigned r; asm volatile("v_cvt_pk_bf16_f32 %0, %1, %2" : "=v"(r) : "v"(lo), "v"(hi)); return r; }
template <class Epi, class Sched, bool ALIGN_EPI = false, bool SP2 = false>
__device__ __forceinline__ void gemm_phase(PG8_LAS unsigned char* lds, const Gemm g, const Sched& S, const Epi& E) {
    const int tid = threadIdx.x, wid = __builtin_amdgcn_readfirstlane(tid >> 6), lane = tid & 63, wr = wid >> 2, wc = wid & 3, fr = lane & 15, fq = lane >> 4;
    const int K = g.K, nt = K / BK;
    unsigned voffA[2], voffB[2];
#pragma unroll
    for (int i = 0; i < 2; ++i) { int R, C; stage_rc(tid * 16 + i * 8192, R, C); const int Rb = Epi::PERM ? ((R & ~31) + perm32(R & 31)) : R;
        voffA[i] = (unsigned)(R * K + C) * 2u; voffB[i] = (unsigned)(Rb * K + C) * 2u; }
    const size_t kstep = (size_t)(BK * 2);
    const size_t hstep = (size_t)HALF * K * 2;
    const size_t tstep = 2 * hstep;
    const unsigned ldsw = (unsigned)wid * 1024u;
    const int aoff = lds_byte(wr * 64 + fr, fq * 8), boff = lds_byte(wc * 32 + fr, fq * 8);
#define PG8_SA(b, h) (((b) * 2 + (h)) * HTB)
#define PG8_SB(b, h) ((4 + (b) * 2 + (h)) * HTB)
#define PG8_STAGE(bufoff, gbase, voff) do { _Pragma("unroll") for (int _i = 0; _i < 2; ++_i) \
        __builtin_amdgcn_global_load_lds((const unsigned*)((const char*)(gbase) + (voff)[_i]), (PG8_LAS unsigned*)(lds + (bufoff) + ldsw + _i * 8192), 16, 0, 0); } while (0)
#define PG8_LDA(dst, b, h) do { _Pragma("unroll") for (int m = 0; m < 4; ++m) _Pragma("unroll") for (int k = 0; k < 2; ++k) dst[m][k] = *(const PG8_LAS bf16x8*)(lds + PG8_SA(b, h) + aoff + m * 2048 + k * 1024); } while (0)
#define PG8_LDB(dst, b, h) do { _Pragma("unroll") for (int n = 0; n < 2; ++n) _Pragma("unroll") for (int k = 0; k < 2; ++k) dst[n][k] = *(const PG8_LAS bf16x8*)(lds + PG8_SB(b, h) + boff + n * 2048 + k * 1024); } while (0)
#define PG8_MMA(ai, bj, At, Bt) do { __builtin_amdgcn_s_setprio(1); _Pragma("unroll") for (int m = 0; m < 4; ++m) _Pragma("unroll") for (int n = 0; n < 2; ++n) _Pragma("unroll") for (int k = 0; k < 2; ++k) \
        acc[ai][bj][m][n] = __builtin_amdgcn_mfma_f32_16x16x32_bf16(Bt[n][k], At[m][k], acc[ai][bj][m][n], 0, 0, 0); __builtin_amdgcn_s_setprio(0); } while (0)
#define PG8_WAIT_V(n) asm volatile("s_waitcnt vmcnt(" #n ")" ::: "memory")
#define PG8_WAIT_L(n) asm volatile("s_waitcnt lgkmcnt(" #n ")" ::: "memory")
#define PG8_BAR __builtin_amdgcn_s_barrier()
#define PG8_SCHED __builtin_amdgcn_sched_barrier(0)
    Unit cur, nxt; int ui = 0;
    if (!S.next(0, cur)) return;
    f32x4 acc[2][2][4][2];
#pragma unroll
    for (int a = 0; a < 2; ++a)
#pragma unroll
        for (int b = 0; b < 2; ++b)
#pragma unroll
            for (int m = 0; m < 4; ++m)
#pragma unroll
                for (int n = 0; n < 2; ++n) acc[a][b][m][n] = (f32x4){0.f, 0.f, 0.f, 0.f};
    bf16x8 At[4][2], B0[2][2], B1[2][2];
    const char* cA = (const char*)g.A + (size_t)cur.pm * tstep; const char* cB = (const char*)g.Bt + (size_t)cur.pn * tstep;
    S.a_ready(cur);
    if constexpr (SP2) {
        PG8_STAGE(PG8_SB(0, 0), cB, voffB); PG8_STAGE(PG8_SB(0, 1), cB + hstep, voffB); PG8_STAGE(PG8_SA(0, 0), cA, voffA); PG8_STAGE(PG8_SA(0, 1), cA + hstep, voffA);
        if (wr == 1) PG8_BAR;
        PG8_WAIT_V(2); PG8_BAR;
        PG8_STAGE(PG8_SB(1, 0), cB + kstep, voffB); PG8_STAGE(PG8_SA(1, 0), cA + kstep, voffA); PG8_STAGE(PG8_SB(1, 1), cB + hstep + kstep, voffB);
        PG8_WAIT_V(6); PG8_BAR;
    } else {
        PG8_STAGE(PG8_SB(0, 0), cB, voffB); PG8_STAGE(PG8_SA(0, 0), cA, voffA); PG8_STAGE(PG8_SB(0, 1), cB + hstep, voffB); PG8_STAGE(PG8_SA(0, 1), cA + hstep, voffA);
        if (wr == 1) PG8_BAR;
        PG8_WAIT_V(4); PG8_BAR;
        PG8_STAGE(PG8_SB(1, 0), cB + kstep, voffB); PG8_STAGE(PG8_SA(1, 0), cA + kstep, voffA); PG8_STAGE(PG8_SB(1, 1), cB + hstep + kstep, voffB);
        PG8_WAIT_V(6); PG8_BAR;
    }
    for (;;) {
        const bool has_next = S.next(ui + 1, nxt);
        const char* nA = has_next ? (const char*)g.A + (size_t)nxt.pm * tstep : cA; const char* nB = has_next ? (const char*)g.Bt + (size_t)nxt.pn * tstep : cB;
        for (int t = 0; t < nt; t += 2) {
            const bool last = (t == nt - 2);
            const char* a1 = cA + (size_t)(t + 1) * kstep;
            const char* a2 = last ? nA : cA + (size_t)(t + 2) * kstep; const char* b2 = last ? nB : cB + (size_t)(t + 2) * kstep;
            const char* a3 = a2 + kstep; const char* b3 = b2 + kstep;
            if (last && has_next) S.a_ready(nxt);
            if constexpr (SP2) {
            PG8_LDB(B0, 0, 0); PG8_LDB(B1, 0, 1); PG8_SCHED; PG8_LDA(At, 0, 0); PG8_STAGE(PG8_SA(1, 1), a1 + hstep, voffA);
            PG8_WAIT_V(8); PG8_WAIT_L(0); PG8_BAR; PG8_MMA(0, 0, At, B0); PG8_MMA(0, 1, At, B1); PG8_BAR; PG8_SCHED;
            PG8_LDA(At, 0, 1); PG8_STAGE(PG8_SB(0, 0), b2, voffB); PG8_STAGE(PG8_SB(0, 1), b2 + hstep, voffB); PG8_STAGE(PG8_SA(0, 0), a2, voffA);
            PG8_WAIT_V(8); PG8_WAIT_L(0); PG8_BAR; PG8_MMA(1, 0, At, B0); PG8_MMA(1, 1, At, B1); PG8_BAR; PG8_SCHED;
            PG8_LDB(B0, 1, 0); PG8_LDB(B1, 1, 1); PG8_SCHED; PG8_LDA(At, 1, 0); PG8_STAGE(PG8_SA(0, 1), a2 + hstep, voffA);
            PG8_WAIT_V(8); PG8_WAIT_L(0); PG8_BAR; PG8_MMA(0, 0, At, B0); PG8_MMA(0, 1, At, B1); PG8_BAR; PG8_SCHED;
            PG8_LDA(At, 1, 1); PG8_STAGE(PG8_SB(1, 0), b3, voffB); PG8_STAGE(PG8_SB(1, 1), b3 + hstep, voffB); PG8_STAGE(PG8_SA(1, 0), a3, voffA);
            PG8_WAIT_V(8); PG8_WAIT_L(0); PG8_BAR; PG8_MMA(1, 0, At, B0); PG8_MMA(1, 1, At, B1); PG8_BAR; PG8_SCHED;
            } else {
            PG8_LDB(B0, 0, 0); PG8_SCHED; PG8_LDA(At, 0, 0); PG8_STAGE(PG8_SA(1, 1), a1 + hstep, voffA);
            PG8_WAIT_L(8); PG8_BAR; PG8_WAIT_L(0); PG8_MMA(0, 0, At, B0); PG8_BAR; PG8_SCHED;
            PG8_LDB(B1, 0, 1); PG8_STAGE(PG8_SB(0, 0), b2, voffB);
            PG8_BAR; PG8_WAIT_L(0); PG8_MMA(0, 1, At, B1); PG8_BAR;
            PG8_LDA(At, 0, 1); PG8_STAGE(PG8_SA(0, 0), a2, voffA);
            PG8_BAR; PG8_WAIT_L(0); PG8_MMA(1, 0, At, B0); PG8_BAR; PG8_SCHED;
            PG8_STAGE(PG8_SB(0, 1), b2 + hstep, voffB);
            PG8_WAIT_V(6); PG8_BAR; PG8_MMA(1, 1, At, B1); PG8_BAR;
            PG8_LDB(B0, 1, 0); PG8_SCHED; PG8_LDA(At, 1, 0); PG8_STAGE(PG8_SA(0, 1), a2 + hstep, voffA);
            PG8_WAIT_L(8); PG8_BAR; PG8_WAIT_L(0); PG8_MMA(0, 0, At, B0); PG8_BAR; PG8_SCHED;
            PG8_LDB(B1, 1, 1); PG8_STAGE(PG8_SB(1, 0), b3, voffB);
            PG8_BAR; PG8_WAIT_L(0); PG8_MMA(0, 1, At, B1); PG8_BAR;
            PG8_LDA(At, 1, 1); PG8_STAGE(PG8_SA(1, 0), a3, voffA);
            PG8_BAR; PG8_WAIT_L(0); PG8_MMA(1, 0, At, B0); PG8_BAR; PG8_SCHED;
            PG8_STAGE(PG8_SB(1, 1), b3 + hstep, voffB);
            PG8_WAIT_V(6); PG8_BAR; PG8_MMA(1, 1, At, B1); PG8_BAR;
            }
        }
        if constexpr (ALIGN_EPI) { if (wr == 0) PG8_BAR; }
        if constexpr (!Epi::AFTER_DRAIN) { E(acc, cur, wr, wc, fr, fq); S.done(cur); }
        if (!has_next) break;
#pragma unroll
        for (int a = 0; a < 2; ++a)
#pragma unroll
            for (int b = 0; b < 2; ++b)
#pragma unroll
                for (int m = 0; m < 4; ++m)
#pragma unroll
                    for (int n = 0; n < 2; ++n) acc[a][b][m][n] = (f32x4){0.f, 0.f, 0.f, 0.f};
        cur = nxt; cA = nA; cB = nB; ++ui;
        if constexpr (ALIGN_EPI) { if (wr == 1) PG8_BAR; }
    }
    PG8_WAIT_V(0);
    if constexpr (!ALIGN_EPI) { if (wr == 0) PG8_BAR; }
    PG8_BAR;
    if constexpr (Epi::AFTER_DRAIN) { E.fused(acc, cur, wr, wc, fr, fq, lds, wid, lane); S.done(cur); }
#undef PG8_SA
#undef PG8_SB
#undef PG8_STAGE
#undef PG8_LDA
#undef PG8_LDB
#undef PG8_MMA
#undef PG8_WAIT_V
#undef PG8_WAIT_L
#undef PG8_BAR
#undef PG8_SCHED
}
}
#define GAS __attribute__((address_space(1)))
#define LAS __attribute__((address_space(3)))
typedef unsigned short bf16;
typedef unsigned v4u __attribute__((ext_vector_type(4)));
typedef float f32x4 __attribute__((ext_vector_type(4)));
typedef short bf16x8 __attribute__((ext_vector_type(8)));
typedef GAS unsigned gu32;
typedef GAS unsigned long long gu64;
#define RLX_AGENT __ATOMIC_RELAXED, __HIP_MEMORY_SCOPE_AGENT
#define LDS_WAIT() asm volatile("s_waitcnt lgkmcnt(0)" ::: "memory")
#define VM_WAIT() asm volatile("s_waitcnt vmcnt(0)" ::: "memory")
__device__ __forceinline__ unsigned long long rt() { return __builtin_amdgcn_s_memrealtime(); }
__device__ __forceinline__ unsigned f2bf(float f) { unsigned u = __builtin_bit_cast(unsigned, f); return (u + 0x7fffu + ((u >> 16) & 1u)) >> 16; }
__device__ __forceinline__ unsigned pk2(float lo, float hi) { return f2bf(lo) | (f2bf(hi) << 16); }

#define XB_TMO      128
#define XB_XCNT(j)  (256  + 64 * (j))
#define XB_XSUB(j)  (1280 + 64 * (j))
#define XB_XGEN(j)  (2304 + 64 * (j))
#define XB_TOP      3328
#define XB_TOPGEN   3392
#define XCD_BAR_WORDS 3456
#define XB_SPIN_CAP (1u << 18)

__device__ __forceinline__ unsigned xb_ld(unsigned* p)              { return __hip_atomic_load(p, __ATOMIC_RELAXED, __HIP_MEMORY_SCOPE_AGENT); }
__device__ __forceinline__ unsigned xb_add(unsigned* p, unsigned v) { return __hip_atomic_fetch_add(p, v, __ATOMIC_RELAXED, __HIP_MEMORY_SCOPE_AGENT); }
__device__ __forceinline__ unsigned xb_xcc_id() { return (unsigned)__builtin_amdgcn_s_getreg((3 << 11) | 20) & 0xFu; }
#define XB_SPIN(cond, bar) do { unsigned _sp = 0; while (cond) { __builtin_amdgcn_s_sleep(1); \
    if ((++_sp & 255u) == 0u) { if (xb_ld(&(bar)[XB_TMO])) break; if (_sp > XB_SPIN_CAP) { atomicAdd(&(bar)[XB_TMO], 1u); break; } } } } while (0)

struct XcdBarrier {
    unsigned* bar; unsigned x;
    volatile LAS unsigned* st;
};

__device__ __forceinline__ XcdBarrier xcd_barrier_post(unsigned* bar, volatile LAS unsigned* st) {
    XcdBarrier b; b.bar = bar; b.x = xb_xcc_id(); b.st = st;
    if (threadIdx.x == 0) (void)xb_add(&bar[XB_XCNT(b.x)], 1u);
    return b;
}
__device__ __forceinline__ void xcd_barrier_complete(unsigned* bar, unsigned x, unsigned& nloc, unsigned& nx) {
    const unsigned G = gridDim.x * gridDim.y * gridDim.z;
    unsigned sum, cnt, mine, sp = 0u;
    for (;;) {
        sum = 0u; cnt = 0u; mine = 0u;
#pragma unroll
        for (unsigned j = 0; j < 16; ++j) { const unsigned c = xb_ld(&bar[XB_XCNT(j)]); sum += c; cnt += (c > 0u) ? 1u : 0u; mine = (j == x) ? c : mine; }
        if (sum == G) break;
        __builtin_amdgcn_s_sleep(1);
        if ((++sp & 255u) == 0u) { if (xb_ld(&bar[XB_TMO])) break; if (sp > XB_SPIN_CAP) { atomicAdd(&bar[XB_TMO], 1u); break; } }
    }
    nloc = mine > 0u ? mine : 1u; nx = cnt > 0u ? cnt : 1u;
}

__device__ __forceinline__ void xcd_barrier(const XcdBarrier& b) {
    asm volatile("s_waitcnt vmcnt(0)" ::: "memory");
    __syncthreads();
    if (threadIdx.x == 0) {
        unsigned* bar = b.bar; asm volatile("" : "+s"(bar));
        __builtin_amdgcn_s_waitcnt(0);
        unsigned nloc = b.st[0], nx = b.st[1];
        if (nloc == 0u) { unsigned bx = b.x; asm volatile("" : "+s"(bx)); xcd_barrier_complete(bar, bx, nloc, nx); b.st[0] = nloc; b.st[1] = nx; }
        const unsigned old = xb_add(&bar[XB_XSUB(b.x)], 1u);
        const unsigned gen = old / nloc;
        if (old + 1u == (gen + 1u) * nloc) {
            __builtin_amdgcn_fence(__ATOMIC_RELEASE, "agent");
            asm volatile("s_waitcnt vmcnt(0)" ::: "memory");
            const unsigned og = xb_add(&bar[XB_TOP], 1u);
            const unsigned tg = og / nx;
            if (og + 1u == (tg + 1u) * nx) xb_add(&bar[XB_TOPGEN], 1u);
            else XB_SPIN(xb_ld(&bar[XB_TOPGEN]) == tg, bar);
            __builtin_amdgcn_fence(__ATOMIC_ACQUIRE, "agent");
            xb_add(&bar[XB_XGEN(b.x)], 1u);
            asm volatile("s_waitcnt vmcnt(0)" ::: "memory");
        } else {
            XB_SPIN(xb_ld(&bar[XB_XGEN(b.x)]) == gen, bar);
            __builtin_amdgcn_fence(__ATOMIC_ACQUIRE, "agent");
            asm volatile("s_waitcnt vmcnt(0)" ::: "memory");
        }
    }
    __syncthreads();
}

constexpr int NWAVES = 8;
#ifndef MK_N_LAUNCHES
#define MK_N_LAUNCHES 12
#endif
constexpr int N_PHASES = 12;
constexpr int N_LAUNCHES = MK_N_LAUNCHES;

constexpr int DM = 4096, MROWS = 9216, NPROMPT = 8192, NSEQ = 132, INC = 10240, MODW = 12288;
constexpr int OFF_AB = 0, OFF_AC = 1024, OFF_AX = 2048, OFF_AG = 3072, OFF_BX = 4096, OFF_BG = 6144, OFF_CU = 8192, OFF_CG = 9216;
constexpr float RMS_EPS = 1e-6f;
constexpr size_t O_Y = 0;
constexpr size_t O_PCA = (size_t)MROWS * DM;
constexpr size_t O_PCB = O_PCA + 2 * 4 * 2 * 1024;
constexpr size_t O_PH  = O_PCB + 2 * 4 * 3 * 2048;
constexpr size_t O_PRE = O_PH + 2 * 4 * 2048;
constexpr size_t O_PIM = O_PRE + 2 * 4 * 4096;
constexpr size_t O_SCA = O_PIM + 2 * 4 * 4096;
constexpr size_t O_SCB = O_SCA + 2 * 128 * 2 * 1024;
constexpr size_t O_SH  = O_SCB + 2 * 128 * 3 * 2048;
constexpr size_t O_SRE = O_SH + 2 * 128 * 2048;
constexpr size_t O_SIM = O_SRE + 2 * 128 * 4096;
constexpr size_t O_END = O_SIM + 2 * 128 * 4096;
static_assert(O_END == 42614784, "output size");
constexpr size_t MiB = 1u << 20;
constexpr size_t WS_CTL = 0, CTL_ZERO_BYTES = 1 * MiB;
constexpr size_t WS_WINT = 2 * MiB;
constexpr size_t WS_WOUTT = 162 * MiB;
constexpr size_t WS_WGLUT = 226 * MiB;
constexpr size_t WS_WRGT = 230 * MiB;
constexpr size_t WS_WIGT = 231 * MiB;
constexpr size_t WS_S5M = 232 * MiB, S5M_STRIDE = 131072;
constexpr size_t WS_MOD = 248 * MiB;
constexpr size_t WS_H = 262 * MiB;
constexpr size_t WS_PROJ = 334 * MiB;
constexpr size_t WS_MIX = 514 * MiB;
constexpr size_t WS_X1 = 586 * MiB;
constexpr size_t WS_YG = 730 * MiB;
constexpr size_t WS_HLOC = 748 * MiB;
constexpr size_t WS_PCUM = 820 * MiB;
constexpr size_t WS_SUMA = 892 * MiB, WS_SUMH = 893 * MiB;
constexpr size_t WS_END = 894 * MiB;
constexpr int CW_BAR = 4096;
constexpr int RING_OFF = 0;
constexpr int LDS_BYTES = 147456;
constexpr int LDSCTL_OFF = LDS_BYTES - 1024, MISC_OFF = LDSCTL_OFF + 320, PTR_OFF = LDSCTL_OFF + 512;

typedef unsigned u32x2 __attribute__((ext_vector_type(2)));
__device__ __forceinline__ float bflo(unsigned u) { return __builtin_bit_cast(float, u << 16); }
__device__ __forceinline__ float bfhi(unsigned u) { return __builtin_bit_cast(float, u & 0xffff0000u); }
__device__ __forceinline__ float sigm(float x) { return __builtin_amdgcn_rcpf(1.0f + __expf(-x)); }
__device__ __forceinline__ float silu(float x) { return x * sigm(x); }
__device__ __forceinline__ float gelu_tanh(float x) { return x * sigm(1.5957691216f * (x + 0.044715f * x * x * x)); }
#define UNPK8(v, f) do { f[0] = bflo((v).x); f[1] = bfhi((v).x); f[2] = bflo((v).y); f[3] = bfhi((v).y); f[4] = bflo((v).z); f[5] = bfhi((v).z); f[6] = bflo((v).w); f[7] = bfhi((v).w); } while (0)

struct Frame {
    LAS unsigned char* lds;
    volatile LAS unsigned* MISC;
    gu32* ctl;
    int tid, lane, wave, G;
    float* out;
    unsigned char* ws;
};
enum { I_XP = 0, I_XS, I_CP, I_CS, I_SCA, I_SCB, I_SLH, I_SRE, I_SIM, I_GN, I_WADA, I_BADA, I_WIN, I_WCA, I_BCA, I_WCB, I_BCB, I_WRG, I_BRG, I_WIG, I_BIG,
       I_LAM, I_S5LR, I_S5LI, I_S5DT, I_S5BR, I_S5BI, I_S5CR, I_S5CI, I_S5D, I_WGLU, I_BGLU, I_WOUT, I_GFIN };

template <class T> __device__ __forceinline__ T* launder(T* p) { asm volatile("" : "+s"(p)); return p; }
__device__ __forceinline__ const float* inptr(const Frame& F, int i) {
    volatile LAS unsigned* t = (volatile LAS unsigned*)(F.lds + PTR_OFF);
    const unsigned lo = __builtin_amdgcn_readfirstlane(t[2 * i]), hi = __builtin_amdgcn_readfirstlane(t[2 * i + 1]);
    return (const float*)(((unsigned long long)hi << 32) | (unsigned long long)lo);
}
__device__ __forceinline__ float wave_sum(float v) {
#pragma unroll
    for (int o = 1; o < 64; o <<= 1) v += __shfl_xor(v, o);
    return v;
}
__device__ __forceinline__ int seq_of_row(int row) { return row < NPROMPT ? (row >> 11) : 4 + ((row - NPROMPT) >> 3); }

__device__ __forceinline__ void p0_transpose_item(const float* W, int K, int N, bf16* WT, LAS float* scr, int item, int lane) {
    const int nblk = N / 32, kb = item / nblk, nb = item % nblk, k0 = 64 * kb, n0 = 32 * nb;
#pragma unroll 8
    for (int i = 0; i < 32; ++i) { const int kk = 2 * i + (lane >> 5); scr[kk * 33 + (lane & 31)] = W[(size_t)(k0 + kk) * N + n0 + (lane & 31)]; }
    LDS_WAIT(); asm volatile("" ::: "memory");
    const int c = lane & 7;
#pragma unroll
    for (int j = 0; j < 4; ++j) { const int n = (lane >> 3) + 8 * j; const LAS float* s = scr + (8 * c) * 33 + n;
        v4u o; o.x = pk2(s[0 * 33], s[1 * 33]); o.y = pk2(s[2 * 33], s[3 * 33]); o.z = pk2(s[4 * 33], s[5 * 33]); o.w = pk2(s[6 * 33], s[7 * 33]);
        *(GAS v4u*)(WT + (size_t)(n0 + n) * K + k0 + 8 * c) = o; }
    LDS_WAIT(); asm volatile("" ::: "memory");
}
__device__ __forceinline__ void p0_transposes(const Frame& F) {
    LAS float* scr = (LAS float*)(F.lds + F.wave * 16384);
    const int gw = blockIdx.x * NWAVES + F.wave, NGW = F.G * NWAVES;
    constexpr int I_IN = 64 * 320, I_OUT = 64 * 128, I_GLU = 16 * 32, I_HG = 16 * 8;
    constexpr int PER_L = I_IN + I_OUT + I_GLU + 2 * I_HG;
    for (int it = gw; it < 2 * PER_L; it += NGW) {
        const int l = it / PER_L; int r = it % PER_L;
        if (r < I_IN) { p0_transpose_item(inptr(F, I_WIN) + (size_t)l * 4096 * 10240, 4096, 10240, (bf16*)(F.ws + WS_WINT) + (size_t)l * 10240 * 4096, scr, r, F.lane); continue; } r -= I_IN;
        if (r < I_OUT) { p0_transpose_item(inptr(F, I_WOUT) + (size_t)l * 4096 * 4096, 4096, 4096, (bf16*)(F.ws + WS_WOUTT) + (size_t)l * 4096 * 4096, scr, r, F.lane); continue; } r -= I_OUT;
        if (r < I_GLU) { p0_transpose_item(inptr(F, I_WGLU) + (size_t)l * 1024 * 1024, 1024, 1024, (bf16*)(F.ws + WS_WGLUT) + (size_t)l * 1024 * 1024, scr, r, F.lane); continue; } r -= I_GLU;
        if (r < I_HG) { const int hd = r >> 3; p0_transpose_item(inptr(F, I_WRG) + (size_t)(l * 16 + hd) * 16384, 128, 128, (bf16*)(F.ws + WS_WRGT) + (size_t)(l * 16 + hd) * 16384, scr, r & 7, F.lane); continue; } r -= I_HG;
        { const int hd = r >> 3; p0_transpose_item(inptr(F, I_WIG) + (size_t)(l * 16 + hd) * 16384, 128, 128, (bf16*)(F.ws + WS_WIGT) + (size_t)(l * 16 + hd) * 16384, scr, r & 7, F.lane); }
    }
}

__device__ __forceinline__ void adaln_task(const Frame& F, int l, int cb) {
    const int tid = F.tid, lane = F.lane, w = F.wave, fr = lane & 15, fq = lane >> 4;
    LAS bf16* As = (LAS bf16*)(F.lds);
    LAS bf16* Bs = (LAS bf16*)(F.lds + 144 * 72 * 2);
    const float* W = inptr(F, I_WADA) + (size_t)l * 4096 * MODW; const int n0 = cb * 96;
    const float* cp = inptr(F, I_CP); const float* cs = inptr(F, I_CS);
    for (int i = tid; i < 12 * 72; i += 512) As[132 * 72 + i] = 0;
    f32x4 acc[7];
#pragma unroll
    for (int j = 0; j < 7; ++j) acc[j] = (f32x4){0.f, 0.f, 0.f, 0.f};
    f32x4 wv[3], cv[5];
#define ADA_LOAD(kt) do { \
    _Pragma("unroll") for (int i = 0; i < 3; ++i) { const int idx = tid + 512 * i, k = idx / 24, n4 = idx % 24; wv[i] = *(const f32x4*)(W + (size_t)((kt) * 64 + k) * MODW + n0 + 4 * n4); } \
    _Pragma("unroll") for (int i = 0; i < 5; ++i) { const int idx = tid + 512 * i, row = idx >> 4, k4 = idx & 15; \
        if (row < NSEQ) { const float* cr = row < 4 ? cp + (size_t)row * 4096 : cs + (size_t)(row - 4) * 4096; cv[i] = *(const f32x4*)(cr + (kt) * 64 + 4 * k4); } else cv[i] = (f32x4){0.f, 0.f, 0.f, 0.f}; } } while (0)
    ADA_LOAD(0);
    for (int kt = 0; kt < 64; ++kt) {
#pragma unroll
        for (int i = 0; i < 3; ++i) { const int idx = tid + 512 * i, k = idx / 24, n4 = idx % 24;
            Bs[(4 * n4 + 0) * 72 + k] = (bf16)f2bf(wv[i].x); Bs[(4 * n4 + 1) * 72 + k] = (bf16)f2bf(wv[i].y); Bs[(4 * n4 + 2) * 72 + k] = (bf16)f2bf(wv[i].z); Bs[(4 * n4 + 3) * 72 + k] = (bf16)f2bf(wv[i].w); }
#pragma unroll
        for (int i = 0; i < 5; ++i) { const int idx = tid + 512 * i, row = idx >> 4, k4 = idx & 15;
            if (row < NSEQ) { u32x2 o; o.x = pk2(cv[i].x, cv[i].y); o.y = pk2(cv[i].z, cv[i].w); *(LAS u32x2*)(As + row * 72 + 4 * k4) = o; } }
        __syncthreads();
        if (kt + 1 < 64) ADA_LOAD(kt + 1);
#pragma unroll
        for (int jj = 0; jj < 7; ++jj) { const int j = w + 8 * jj; if (j < 54) { const int mt = j / 6, nt = j % 6;
#pragma unroll
            for (int ks = 0; ks < 2; ++ks) { const bf16x8 a = *(const LAS bf16x8*)(As + (16 * mt + fr) * 72 + 32 * ks + 8 * fq); const bf16x8 b = *(const LAS bf16x8*)(Bs + (16 * nt + fr) * 72 + 32 * ks + 8 * fq);
                acc[jj] = __builtin_amdgcn_mfma_f32_16x16x32_bf16(a, b, acc[jj], 0, 0, 0); } } }
        __syncthreads();
    }
#undef ADA_LOAD
    float* MOD = (float*)(F.ws + WS_MOD); const float* bada = inptr(F, I_BADA) + (size_t)l * MODW;
#pragma unroll
    for (int jj = 0; jj < 7; ++jj) { const int j = w + 8 * jj; if (j < 54) { const int mt = j / 6, nt = j % 6; const int n = n0 + 16 * nt + fr; const float bb = bada[n];
#pragma unroll
        for (int rg = 0; rg < 4; ++rg) { const int row = 16 * mt + 4 * fq + rg; if (row < NSEQ) MOD[(size_t)(l * NSEQ + row) * MODW + n] = acc[jj][rg] + bb; } } }
}

__device__ __forceinline__ void s5_mats(const Frame& F, int l, int g) {
    LAS float* PWr = (LAS float*)F.lds;
    LAS float* PWi = PWr + 9 * 64;
    LAS float* BBr = PWi + 9 * 64;
    LAS float* BBi = BBr + 1024;
    LAS float* CR = BBi + 1024;
    LAS float* CI = CR + 1024;
    LAS float* KT = CI + 1024;
    LAS float* DD = KT + 2048;
    const int tid = F.tid; const int lg = l * 64 + g;
    unsigned char* mb = F.ws + WS_S5M + (size_t)lg * S5M_STRIDE;
    if (tid < 64) {
        const int p = tid; const float dt = expf(inptr(F, I_S5DT)[lg]); const float lre = inptr(F, I_S5LR)[lg * 64 + p], lim = inptr(F, I_S5LI)[lg * 64 + p];
        const float mag = expf(lre * dt), ang = lim * dt; const float ar = mag * cosf(ang), ai = mag * sinf(ang);
        const float nr = ar - 1.0f, den = lre * lre + lim * lim; const float fr_ = (nr * lre + ai * lim) / den, fi_ = (ai * lre - nr * lim) / den;
        float pr = 1.f, pi = 0.f;
        for (int k = 0; k < 9; ++k) { PWr[k * 64 + p] = pr; PWi[k * 64 + p] = pi; const float t = pr * ar - pi * ai; pi = pr * ai + pi * ar; pr = t; }
        for (int j = 0; j < 16; ++j) { const float bre = inptr(F, I_S5BR)[(size_t)(lg * 64 + p) * 16 + j], bim = inptr(F, I_S5BI)[(size_t)(lg * 64 + p) * 16 + j];
            BBr[p * 16 + j] = fr_ * bre - fi_ * bim; BBi[p * 16 + j] = fr_ * bim + fi_ * bre; }
        float* A8P = (float*)(mb + 98304); const float a8r = PWr[8 * 64 + p], a8i = PWi[8 * 64 + p]; float qr = a8r, qi = a8i;
        for (int k = 0; k < 4; ++k) { A8P[k * 128 + p] = qr; A8P[k * 128 + 64 + p] = qi; const float t = qr * a8r - qi * a8i; qi = qr * a8i + qi * a8r; qr = t; }
    }
    for (int i = tid; i < 1024; i += 512) { CR[i] = inptr(F, I_S5CR)[(size_t)lg * 1024 + i]; CI[i] = inptr(F, I_S5CI)[(size_t)lg * 1024 + i]; }
    if (tid < 16) DD[tid] = inptr(F, I_S5D)[lg * 16 + tid];
    __syncthreads();
    for (int e = tid; e < 2048; e += 512) { const int d = e >> 8, i = (e >> 4) & 15, j = e & 15; float s = 0.f;
        for (int p = 0; p < 64; ++p) { const float pr = PWr[d * 64 + p], pi = PWi[d * 64 + p], br = BBr[p * 16 + j], bi = BBi[p * 16 + j];
            const float zr = pr * br - pi * bi, zi = pr * bi + pi * br; s += CR[i * 64 + p] * zr - CI[i * 64 + p] * zi; }
        KT[e] = s; }
    __syncthreads();
    bf16* KM = (bf16*)mb; bf16* G8 = (bf16*)(mb + 32768); bf16* E8 = (bf16*)(mb + 65536);
    for (int q = tid; q < 2048; q += 512) { const int n = q >> 4, k0 = (q & 15) * 8;
        float v[8];
        { const int t = n >> 4, i = n & 15, s = k0 >> 4, j0 = k0 & 15;
#pragma unroll
          for (int e = 0; e < 8; ++e) { const int j = j0 + e; v[e] = (s <= t) ? (KT[((t - s) * 16 + i) * 16 + j] + ((s == t && i == j) ? DD[i] : 0.f)) : 0.f; }
          v4u o; o.x = pk2(v[0], v[1]); o.y = pk2(v[2], v[3]); o.z = pk2(v[4], v[5]); o.w = pk2(v[6], v[7]); *(v4u*)(KM + n * 128 + k0) = o; }
        { const int pb = n >> 5, ri = (n >> 4) & 1, p = 16 * pb + (n & 15), s = k0 >> 4, j0 = k0 & 15; const float pr = PWr[(7 - s) * 64 + p], pi = PWi[(7 - s) * 64 + p];
#pragma unroll
          for (int e = 0; e < 8; ++e) { const float br = BBr[p * 16 + j0 + e], bi = BBi[p * 16 + j0 + e]; v[e] = ri ? (pr * bi + pi * br) : (pr * br - pi * bi); }
          v4u o; o.x = pk2(v[0], v[1]); o.y = pk2(v[2], v[3]); o.z = pk2(v[4], v[5]); o.w = pk2(v[6], v[7]); *(v4u*)(G8 + n * 128 + k0) = o; }
        { const int t = n >> 4, i = n & 15, pb = k0 >> 5, ri = (k0 >> 4) & 1, p0 = 16 * pb + (k0 & 15);
#pragma unroll
          for (int e = 0; e < 8; ++e) { const int p = p0 + e; const float ar = PWr[(t + 1) * 64 + p], ai = PWi[(t + 1) * 64 + p], cr = CR[i * 64 + p], ci = CI[i * 64 + p];
              v[e] = ri ? -(cr * ai + ci * ar) : (cr * ar - ci * ai); }
          v4u o; o.x = pk2(v[0], v[1]); o.y = pk2(v[2], v[3]); o.z = pk2(v[4], v[5]); o.w = pk2(v[6], v[7]); *(v4u*)(E8 + n * 128 + k0) = o; }
    }
    __syncthreads();
}

__device__ __forceinline__ void norm_phase(const Frame& F, const float* xp, const float* xs, int mode, int lm) {
    const int gw = blockIdx.x * NWAVES + F.wave, NGW = F.G * NWAVES, lane = F.lane;
    const float* MOD = (const float*)(F.ws + WS_MOD); bf16* H = (bf16*)(F.ws + WS_H);
    for (int row = gw; row < MROWS; row += NGW) {
        const float* xr = row < NPROMPT ? xp + (size_t)row * DM : xs + (size_t)(row - NPROMPT) * DM;
        f32x4 v[16]; float ss = 0.f;
#pragma unroll
        for (int j = 0; j < 16; ++j) { v[j] = ((const f32x4*)xr)[lane + 64 * j]; ss += (v[j].x * v[j].x + v[j].y * v[j].y) + (v[j].z * v[j].z + v[j].w * v[j].w); }
        ss = wave_sum(ss); const float rstd = 1.0f / sqrtf(ss * (1.0f / DM) + RMS_EPS);
        if (mode == 0) {
            const float* md = MOD + (size_t)(lm * NSEQ + seq_of_row(row)) * MODW; const float* gn = inptr(F, I_GN) + (size_t)lm * DM;
#pragma unroll
            for (int j = 0; j < 16; ++j) { const int col = 4 * (lane + 64 * j); const f32x4 g = *(const f32x4*)(gn + col), sh = *(const f32x4*)(md + col), sc = *(const f32x4*)(md + DM + col);
                const f32x4 o = v[j] * rstd * g * (sc + 1.0f) + sh; u32x2 pk; pk.x = pk2(o.x, o.y); pk.y = pk2(o.z, o.w); *(u32x2*)(H + (size_t)row * DM + col) = pk; }
        } else {
            const float* gn = inptr(F, I_GFIN); float* orow = F.out + O_Y + (size_t)row * DM;
#pragma unroll
            for (int j = 0; j < 16; ++j) { const int col = 4 * (lane + 64 * j); const f32x4 g = *(const f32x4*)(gn + col); *(f32x4*)(orow + col) = v[j] * rstd * g; }
        }
    }
}

struct EpiProj {
    static constexpr bool PERM = true, AFTER_DRAIN = false;
    bf16* O;
    __device__ __forceinline__ void operator()(const f32x4 (&acc)[2][2][4][2], const pg8::Unit& u, int wr, int wc, int fr, int fq) const {
        const int row0 = u.pm * 256 + wr * 64 + fr, col0 = u.pn * 256 + wc * 32 + 8 * fq;
#pragma unroll
        for (int ai = 0; ai < 2; ++ai)
#pragma unroll
            for (int m = 0; m < 4; ++m) { bf16* rowp = O + (size_t)(row0 + ai * 128 + m * 16) * INC + col0;
#pragma unroll
                for (int bj = 0; bj < 2; ++bj) { const f32x4 v0 = acc[ai][bj][m][0], v1 = acc[ai][bj][m][1];
                    v4u w; w.x = pg8::cvt_pk_bf16(v0[0], v0[1]); w.y = pg8::cvt_pk_bf16(v0[2], v0[3]); w.z = pg8::cvt_pk_bf16(v1[0], v1[1]); w.w = pg8::cvt_pk_bf16(v1[2], v1[3]);
                    *(v4u*)(rowp + bj * 128) = w; } }
    }
};
struct EpiResGate {
    static constexpr bool PERM = false, AFTER_DRAIN = false;
    const float* xp; const float* xs; float* out; const float* gate;
    __device__ __forceinline__ void operator()(const f32x4 (&acc)[2][2][4][2], const pg8::Unit& u, int wr, int wc, int fr, int fq) const {
        const int row0 = u.pm * 256 + wr * 64 + fr, col0 = u.pn * 256 + wc * 32 + 4 * fq;
#pragma unroll
        for (int ai = 0; ai < 2; ++ai)
#pragma unroll
            for (int m = 0; m < 4; ++m) { const int row = row0 + ai * 128 + m * 16;
                const float* xr = (row < NPROMPT ? xp + (size_t)row * DM : xs + (size_t)(row - NPROMPT) * DM) + col0;
                const float* gr = gate + (size_t)seq_of_row(row) * MODW + col0; float* orow = out + (size_t)row * DM + col0;
#pragma unroll
                for (int bj = 0; bj < 2; ++bj)
#pragma unroll
                    for (int n = 0; n < 2; ++n) { const int c = bj * 128 + n * 16; const f32x4 xv = *(const f32x4*)(xr + c), gv = *(const f32x4*)(gr + c);
                        *(f32x4*)(orow + c) = xv + gv * acc[ai][bj][m][n]; }
                asm volatile("" ::: "memory"); }
    }
};
struct EpiGlu {
    static constexpr bool PERM = true, AFTER_DRAIN = false;
    const bf16* YG; const bf16* PROJ; const float* bglu; bf16* MIX;
    __device__ __forceinline__ void operator()(const f32x4 (&acc)[2][2][4][2], const pg8::Unit& u, int wr, int wc, int fr, int fq) const {
        const int row0 = u.pm * 256 + wr * 64 + fr, col0 = u.pn * 256 + wc * 32 + 8 * fq;
#pragma unroll
        for (int bj = 0; bj < 2; ++bj) { const int col = col0 + bj * 128; const f32x4 b0 = *(const f32x4*)(bglu + col), b1 = *(const f32x4*)(bglu + col + 4);
#pragma unroll
            for (int ai = 0; ai < 2; ++ai)
#pragma unroll
                for (int m = 0; m < 4; ++m) { const int row = row0 + ai * 128 + m * 16;
                    const v4u yv = *(const v4u*)(YG + (size_t)row * 1024 + col), cv = *(const v4u*)(PROJ + (size_t)row * INC + OFF_CG + col);
                    float y[8], c[8]; UNPK8(yv, y); UNPK8(cv, c);
                    const f32x4 z0 = acc[ai][bj][m][0] + b0, z1 = acc[ai][bj][m][1] + b1; float o[8];
#pragma unroll
                    for (int e = 0; e < 4; ++e) { o[e] = y[e] * sigm(z0[e]) * silu(c[e]); o[4 + e] = y[4 + e] * sigm(z1[e]) * silu(c[4 + e]); }
                    v4u w; w.x = pg8::cvt_pk_bf16(o[0], o[1]); w.y = pg8::cvt_pk_bf16(o[2], o[3]); w.z = pg8::cvt_pk_bf16(o[4], o[5]); w.w = pg8::cvt_pk_bf16(o[6], o[7]);
                    *(v4u*)(MIX + (size_t)row * DM + 3072 + col) = w; } }
    }
};

__device__ __forceinline__ void s5_phase(const Frame& F, int l) {
    const int wg = blockIdx.x; if (wg >= 256) return;
    const int g = wg & 63, pbq = wg >> 6; const int lane = F.lane, w = F.wave, fr = lane & 15, fq = lane >> 4;
    const unsigned char* mb = F.ws + WS_S5M + (size_t)(l * 64 + g) * S5M_STRIDE;
    const bf16* KM = (const bf16*)mb; const bf16* G8 = (const bf16*)(mb + 32768); const bf16* E8 = (const bf16*)(mb + 65536); const float* A8P = (const float*)(mb + 98304);
    const bf16* PROJ = (const bf16*)(F.ws + WS_PROJ); bf16* YG = (bf16*)(F.ws + WS_YG);
    bf16x8 BK[4], BE[4], BG0[4], BG1[4];
#pragma unroll
    for (int kk = 0; kk < 4; ++kk) { BK[kk] = *(const bf16x8*)(KM + (16 * w + fr) * 128 + 32 * kk + 8 * fq); BE[kk] = *(const bf16x8*)(E8 + (16 * w + fr) * 128 + 32 * kk + 8 * fq); }
    const int wg2 = (w & 3);
#pragma unroll
    for (int kk = 0; kk < 4; ++kk) { BG0[kk] = *(const bf16x8*)(G8 + (16 * (2 * wg2) + fr) * 128 + 32 * kk + 8 * fq); BG1[kk] = *(const bf16x8*)(G8 + (16 * (2 * wg2 + 1) + fr) * 128 + 32 * kk + 8 * fq); }
    const int p = 16 * wg2 + fr;
    const float a1r = A8P[p], a1i = A8P[64 + p], a2r = A8P[128 + p], a2i = A8P[192 + p], a3r = A8P[256 + p], a3i = A8P[320 + p], a4r = A8P[384 + p], a4i = A8P[448 + p];
    float cr_ = 0.f, ci_ = 0.f;
    LAS bf16* HT = (LAS bf16*)F.lds;
    for (int it = 0; it < 18; ++it) {
        const bool smp = it >= 16;
        const int row0 = smp ? NPROMPT + 128 * (pbq + 4 * (it - 16)) : pbq * 2048 + 128 * it;
        bf16x8 UA[4];
#pragma unroll
        for (int kk = 0; kk < 4; ++kk) UA[kk] = *(const bf16x8*)(PROJ + (size_t)(row0 + 8 * fr + 2 * kk + (fq >> 1)) * INC + OFF_CU + 16 * g + 8 * (fq & 1));
        LAS bf16* hb = HT + (it & 1) * 16 * 136;
        if (w < 4) {
            f32x4 S0 = (f32x4){0.f, 0.f, 0.f, 0.f}, S1 = (f32x4){0.f, 0.f, 0.f, 0.f};
#pragma unroll
            for (int kk = 0; kk < 4; ++kk) { S0 = __builtin_amdgcn_mfma_f32_16x16x32_bf16(UA[kk], BG0[kk], S0, 0, 0, 0); S1 = __builtin_amdgcn_mfma_f32_16x16x32_bf16(UA[kk], BG1[kk], S1, 0, 0, 0); }
            float hr[4], hi[4];
            if (!smp) {
                float Lr[4], Li[4]; Lr[0] = S0[0]; Li[0] = S1[0];
#pragma unroll
                for (int r = 1; r < 4; ++r) { Lr[r] = a1r * Lr[r - 1] - a1i * Li[r - 1] + S0[r]; Li[r] = a1r * Li[r - 1] + a1i * Lr[r - 1] + S1[r]; }
                float tr = cr_, ti = ci_, br = cr_, bi = ci_;
#pragma unroll
                for (int q = 0; q < 4; ++q) { const float er = __shfl(Lr[3], fr + 16 * q), ei = __shfl(Li[3], fr + 16 * q);
                    const float ntr = a4r * tr - a4i * ti + er, nti = a4r * ti + a4i * tr + ei; tr = ntr; ti = nti; if (fq == q + 1) { br = tr; bi = ti; } }
                cr_ = tr; ci_ = ti;
                hr[0] = br; hi[0] = bi;
                hr[1] = a1r * br - a1i * bi + Lr[0]; hi[1] = a1r * bi + a1i * br + Li[0];
                hr[2] = a2r * br - a2i * bi + Lr[1]; hi[2] = a2r * bi + a2i * br + Li[1];
                hr[3] = a3r * br - a3i * bi + Lr[2]; hi[3] = a3r * bi + a3i * br + Li[2];
            } else {
#pragma unroll
                for (int r = 0; r < 4; ++r) { const int b = 16 * (pbq + 4 * (it - 16)) + 4 * fq + r; const size_t si = (size_t)((l * 128 + b) * 64 + g) * 64 + p;
                    hr[r] = inptr(F, I_SRE)[si]; hi[r] = inptr(F, I_SIM)[si];
                    F.out[O_SRE + si] = a1r * hr[r] - a1i * hi[r] + S0[r]; F.out[O_SIM + si] = a1r * hi[r] + a1i * hr[r] + S1[r]; }
            }
#pragma unroll
            for (int r = 0; r < 4; ++r) { hb[(4 * fq + r) * 136 + 32 * w + fr] = (bf16)f2bf(hr[r]); hb[(4 * fq + r) * 136 + 32 * w + 16 + fr] = (bf16)f2bf(hi[r]); }
        }
        __syncthreads();
        f32x4 Y = (f32x4){0.f, 0.f, 0.f, 0.f};
#pragma unroll
        for (int kk = 0; kk < 4; ++kk) { const bf16x8 HA = *(const LAS bf16x8*)(hb + fr * 136 + 32 * kk + 8 * fq);
            Y = __builtin_amdgcn_mfma_f32_16x16x32_bf16(UA[kk], BK[kk], Y, 0, 0, 0); Y = __builtin_amdgcn_mfma_f32_16x16x32_bf16(HA, BE[kk], Y, 0, 0, 0); }
#pragma unroll
        for (int r = 0; r < 4; ++r) { const int row = row0 + 8 * (4 * fq + r) + w; YG[(size_t)row * 1024 + 16 * g + fr] = (bf16)f2bf(gelu_tanh(Y[r])); }
    }
    if (w < 4 && fq == 0) { const size_t si = (size_t)((l * 4 + pbq) * 64 + g) * 64 + p; F.out[O_PRE + si] = cr_; F.out[O_PIM + si] = ci_; }
    __syncthreads();
}

constexpr int B1S = 132;
__device__ __forceinline__ void b1_phase(const Frame& F, int l) {
    LAS float* MAIN = (LAS float*)F.lds;
    LAS float* XB = MAIN + 64 * B1S;
    LAS float* BT = XB + 64 * B1S;
    LAS float* HALO = BT + 64 * B1S;
    LAS float* SEGP = HALO + 8 * 3 * 128;
    LAS float* SEGH = SEGP + 512;
    LAS bf16* XA = (LAS bf16*)(SEGH + 512);
    static_assert(3 * 64 * B1S * 4 + 8 * 3 * 128 * 4 + 2 * 512 * 4 + 64 * 136 * 2 <= LDSCTL_OFF, "B1 LDS");
    const int tid = F.tid, lane = F.lane, w = F.wave, fr = lane & 15, fq = lane >> 4;
    const bf16* PROJ = (const bf16*)(F.ws + WS_PROJ); float* HLOC = (float*)(F.ws + WS_HLOC); float* PCUM = (float*)(F.ws + WS_PCUM);
    float* SUMA = (float*)(F.ws + WS_SUMA); float* SUMH = (float*)(F.ws + WS_SUMH);
    for (int ti = blockIdx.x; ti < 2304; ti += F.G) {
        const int c = ti >> 4, hd = ti & 15; const bool smp = c >= 128; const int row0 = c * 64, ch0 = hd * 128;
#pragma unroll
        for (int i = 0; i < 2; ++i) { const int idx = tid + 512 * i, r = idx >> 4, c8 = idx & 15; const v4u v = *(const v4u*)(PROJ + (size_t)(row0 + r) * INC + OFF_BX + ch0 + 8 * c8);
            float f[8]; UNPK8(v, f); *(LAS f32x4*)(MAIN + r * B1S + 8 * c8) = (f32x4){f[0], f[1], f[2], f[3]}; *(LAS f32x4*)(MAIN + r * B1S + 8 * c8 + 4) = (f32x4){f[4], f[5], f[6], f[7]}; }
        if (!smp) {
            if (tid < 48) { const int j = tid >> 4, c8 = tid & 15; float f[8];
                if ((c & 31) > 0) { const v4u v = *(const v4u*)(PROJ + (size_t)(row0 - 3 + j) * INC + OFF_BX + ch0 + 8 * c8); UNPK8(v, f); }
                else {
#pragma unroll
                    for (int e = 0; e < 8; ++e) f[e] = 0.f; }
                *(LAS f32x4*)(HALO + j * 128 + 8 * c8) = (f32x4){f[0], f[1], f[2], f[3]}; *(LAS f32x4*)(HALO + j * 128 + 8 * c8 + 4) = (f32x4){f[4], f[5], f[6], f[7]}; }
        } else {
#pragma unroll
            for (int i = 0; i < 2; ++i) { const int idx = tid + 512 * i; if (idx < 768) { const int sq = idx / 96, rem = idx % 96, j = rem >> 5, c4 = rem & 31; const int b = 8 * (c - 128) + sq;
                *(LAS f32x4*)(HALO + (sq * 3 + j) * 128 + 4 * c4) = *(const f32x4*)(inptr(F, I_SCB) + (size_t)((l * 128 + b) * 3 + j) * 2048 + ch0 + 4 * c4); } }
        }
        __syncthreads();
        const int ch = tid & 127, sg = tid >> 7;
        {
            const float* wc_ = inptr(F, I_WCB) + (size_t)l * 4 * 2048 + ch0 + ch; const float w0 = wc_[0], w1 = wc_[2048], w2 = wc_[4096], w3 = wc_[6144], bias = inptr(F, I_BCB)[l * 2048 + ch0 + ch];
#pragma unroll 4
            for (int rr = 0; rr < 16; ++rr) { const int r = 16 * sg + rr; const int tt = smp ? (r & 7) : r; const int hb_ = smp ? (r >> 3) * 3 : 0;
                const float x0 = MAIN[r * B1S + ch];
                const float x1 = tt >= 1 ? MAIN[(r - 1) * B1S + ch] : HALO[(hb_ + 2) * 128 + ch];
                const float x2 = tt >= 2 ? MAIN[(r - 2) * B1S + ch] : HALO[(hb_ + 1 + tt) * 128 + ch];
                const float x3 = tt >= 3 ? MAIN[(r - 3) * B1S + ch] : HALO[(hb_ + tt) * 128 + ch];
                const float xb = bias + w3 * x0 + w2 * x1 + w1 * x2 + w0 * x3;
                XB[r * B1S + ch] = xb; XA[r * 136 + ch] = (bf16)f2bf(xb); }
            if (!smp) { if ((c & 31) == 31 && sg == 3) { const int seq = c >> 5;
#pragma unroll
                    for (int j = 0; j < 3; ++j) F.out[O_PCB + (size_t)((l * 4 + seq) * 3 + j) * 2048 + ch0 + ch] = MAIN[(61 + j) * B1S + ch]; } }
            else {
#pragma unroll
                for (int s2 = 0; s2 < 2; ++s2) { const int sq = 2 * sg + s2, b = 8 * (c - 128) + sq;
#pragma unroll
                    for (int j = 0; j < 3; ++j) F.out[O_SCB + (size_t)((l * 128 + b) * 3 + j) * 2048 + ch0 + ch] = MAIN[(8 * sq + 5 + j) * B1S + ch]; } }
        }
        __syncthreads();
        {
            const bf16* WR = (const bf16*)(F.ws + WS_WRGT) + (size_t)((l * 16 + hd) * 128 + 16 * w + fr) * 128 + 8 * fq;
            const bf16* WI = (const bf16*)(F.ws + WS_WIGT) + (size_t)((l * 16 + hd) * 128 + 16 * w + fr) * 128 + 8 * fq;
            bf16x8 BR[4], BI[4];
#pragma unroll
            for (int kk = 0; kk < 4; ++kk) { BR[kk] = *(const bf16x8*)(WR + 32 * kk); BI[kk] = *(const bf16x8*)(WI + 32 * kk); }
            f32x4 zr[4], zi[4];
#pragma unroll
            for (int mt = 0; mt < 4; ++mt) { zr[mt] = (f32x4){0.f, 0.f, 0.f, 0.f}; zi[mt] = (f32x4){0.f, 0.f, 0.f, 0.f}; }
#pragma unroll
            for (int mt = 0; mt < 4; ++mt)
#pragma unroll
                for (int kk = 0; kk < 4; ++kk) { const bf16x8 ax = *(const LAS bf16x8*)(XA + (16 * mt + fr) * 136 + 32 * kk + 8 * fq);
                    zr[mt] = __builtin_amdgcn_mfma_f32_16x16x32_bf16(ax, BR[kk], zr[mt], 0, 0, 0); zi[mt] = __builtin_amdgcn_mfma_f32_16x16x32_bf16(ax, BI[kk], zi[mt], 0, 0, 0); }
            const int chn = 16 * w + fr; const float brg = inptr(F, I_BRG)[(l * 16 + hd) * 128 + chn], big = inptr(F, I_BIG)[(l * 16 + hd) * 128 + chn];
            const float sp8 = -8.0f * log1pf(__expf(-inptr(F, I_LAM)[l * 2048 + ch0 + chn]));
#pragma unroll
            for (int mt = 0; mt < 4; ++mt)
#pragma unroll
                for (int rg = 0; rg < 4; ++rg) { const int r = 16 * mt + 4 * fq + rg; const float rr_ = sigm(zr[mt][rg] + brg), ig = sigm(zi[mt][rg] + big);
                    const float a = __expf(sp8 * rr_); const float beta = sqrtf(fmaxf(1.0f - a * a, 0.f));
                    MAIN[r * B1S + chn] = a; BT[r * B1S + chn] = beta * ig * XB[r * B1S + chn]; }
        }
        __syncthreads();
        float Pl[16], Hl[16];
        { float p = 1.f, h = 0.f;
#pragma unroll
          for (int rr = 0; rr < 16; ++rr) { const int r = 16 * sg + rr; if (smp && (rr & 7) == 0) { p = 1.f; h = 0.f; } const float a = MAIN[r * B1S + ch], b = BT[r * B1S + ch]; h = a * h + b; p = p * a; Pl[rr] = p; Hl[rr] = h; }
          if (!smp) { SEGP[sg * 128 + ch] = p; SEGH[sg * 128 + ch] = h; } }
        __syncthreads();
        { float cP = 1.f, cH = 0.f;
          if (!smp) {
#pragma unroll
              for (int s = 0; s < 3; ++s) if (s < sg) { const float sp_ = SEGP[s * 128 + ch], sh_ = SEGH[s * 128 + ch]; cH = sp_ * cH + sh_; cP *= sp_; } }
#pragma unroll
          for (int rr = 0; rr < 16; ++rr) { const size_t o = (size_t)(row0 + 16 * sg + rr) * 2048 + ch0 + ch; HLOC[o] = Hl[rr] + Pl[rr] * cH; PCUM[o] = Pl[rr] * cP; }
          if (!smp && sg == 3) { SUMA[(size_t)c * 2048 + ch0 + ch] = Pl[15] * cP; SUMH[(size_t)c * 2048 + ch0 + ch] = Hl[15] + Pl[15] * cH; } }
        __syncthreads();
    }
}

__device__ __forceinline__ void mixa_phase(const Frame& F, int l) {
    const bf16* PROJ = (const bf16*)(F.ws + WS_PROJ); bf16* MIX = (bf16*)(F.ws + WS_MIX);
    const int NT = F.G * 512;
    for (int item = blockIdx.x * 512 + F.tid; item < 1152 * 128; item += NT) {
        const int c8 = item >> 7, strip = item & 127, r0 = 8 * c8, ch = 8 * strip; const bool smp = r0 >= NPROMPT; const int t0 = smp ? 0 : (r0 & 2047);
        float w0[8], w1[8], w2[8], bs[8], p2[8], p1[8];
        { const float* wa = inptr(F, I_WCA) + (size_t)l * 3 * 1024 + ch; const float* ba = inptr(F, I_BCA) + l * 1024 + ch;
#pragma unroll
          for (int h = 0; h < 2; ++h) { const f32x4 a = *(const f32x4*)(wa + 4 * h), b = *(const f32x4*)(wa + 1024 + 4 * h), cc = *(const f32x4*)(wa + 2048 + 4 * h), d = *(const f32x4*)(ba + 4 * h);
#pragma unroll
              for (int e = 0; e < 4; ++e) { w0[4 * h + e] = a[e]; w1[4 * h + e] = b[e]; w2[4 * h + e] = cc[e]; bs[4 * h + e] = d[e]; } } }
        if (t0 >= 2) {
            const v4u c2 = *(const v4u*)(PROJ + (size_t)(r0 - 2) * INC + OFF_AC + ch), x2 = *(const v4u*)(PROJ + (size_t)(r0 - 2) * INC + OFF_AX + ch);
            const v4u c1 = *(const v4u*)(PROJ + (size_t)(r0 - 1) * INC + OFF_AC + ch), x1 = *(const v4u*)(PROJ + (size_t)(r0 - 1) * INC + OFF_AX + ch);
            float a[8], b[8]; UNPK8(c2, a); UNPK8(x2, b);
#pragma unroll
            for (int e = 0; e < 8; ++e) p2[e] = a[e] * b[e];
            UNPK8(c1, a); UNPK8(x1, b);
#pragma unroll
            for (int e = 0; e < 8; ++e) p1[e] = a[e] * b[e];
        } else if (!smp) {
#pragma unroll
            for (int e = 0; e < 8; ++e) { p2[e] = 0.f; p1[e] = 0.f; }
        } else { const int b = (r0 - NPROMPT) >> 3; const float* st = inptr(F, I_SCA) + (size_t)((l * 128 + b) * 2) * 1024 + ch;
#pragma unroll
            for (int h = 0; h < 2; ++h) { const f32x4 a = *(const f32x4*)(st + 4 * h), bb = *(const f32x4*)(st + 1024 + 4 * h);
#pragma unroll
                for (int e = 0; e < 4; ++e) { p2[4 * h + e] = a[e]; p1[4 * h + e] = bb[e]; } } }
#pragma unroll
        for (int r = 0; r < 8; ++r) { const bf16* pr = PROJ + (size_t)(r0 + r) * INC + ch;
            const v4u vb = *(const v4u*)(pr + OFF_AB), vc = *(const v4u*)(pr + OFF_AC), vx = *(const v4u*)(pr + OFF_AX), vg = *(const v4u*)(pr + OFF_AG);
            float ab[8], ac[8], ax[8], ag[8], o[8]; UNPK8(vb, ab); UNPK8(vc, ac); UNPK8(vx, ax); UNPK8(vg, ag);
#pragma unroll
            for (int e = 0; e < 8; ++e) { const float cin = ac[e] * ax[e]; const float cv = bs[e] + w0[e] * p2[e] + w1[e] * p1[e] + w2[e] * cin; o[e] = ab[e] * cv * silu(ag[e]); p2[e] = p1[e]; p1[e] = cin; }
            v4u wv; wv.x = pk2(o[0], o[1]); wv.y = pk2(o[2], o[3]); wv.z = pk2(o[4], o[5]); wv.w = pk2(o[6], o[7]); *(v4u*)(MIX + (size_t)(r0 + r) * DM + ch) = wv; }
        if (smp || t0 == 2040) { const int sq = seq_of_row(r0); float* so = F.out + (sq < 4 ? O_PCA + (size_t)((l * 4 + sq) * 2) * 1024 : O_SCA + (size_t)((l * 128 + sq - 4) * 2) * 1024) + ch;
            *(f32x4*)(so) = (f32x4){p2[0], p2[1], p2[2], p2[3]}; *(f32x4*)(so + 4) = (f32x4){p2[4], p2[5], p2[6], p2[7]};
            *(f32x4*)(so + 1024) = (f32x4){p1[0], p1[1], p1[2], p1[3]}; *(f32x4*)(so + 1028) = (f32x4){p1[4], p1[5], p1[6], p1[7]}; }
    }
}

__device__ __forceinline__ void b2_phase(const Frame& F, int l, int wg0) {
    const bf16* PROJ = (const bf16*)(F.ws + WS_PROJ); bf16* MIX = (bf16*)(F.ws + WS_MIX);
    const float* HLOC = (const float*)(F.ws + WS_HLOC); const float* PCUM = (const float*)(F.ws + WS_PCUM);
    const float* SUMA = (const float*)(F.ws + WS_SUMA); const float* SUMH = (const float*)(F.ws + WS_SUMH);
    const int NT = (F.G - wg0) * 512;
    for (int item = (blockIdx.x - wg0) * 512 + F.tid; item < 144 * 1024; item += NT) {
        const int c = item >> 10, rq = (item >> 8) & 3, ch = 8 * (item & 255); const bool smp = c >= 128;
        float hin[8];
#pragma unroll
        for (int e = 0; e < 8; ++e) hin[e] = 0.f;
        if (!smp) { const int cc = c & 31; const float* sa = SUMA + (size_t)(c - cc) * 2048 + ch; const float* sh = SUMH + (size_t)(c - cc) * 2048 + ch;
            for (int k = 0; k < cc; ++k) { const f32x4 a0 = *(const f32x4*)(sa + (size_t)k * 2048), a1 = *(const f32x4*)(sa + (size_t)k * 2048 + 4), h0 = *(const f32x4*)(sh + (size_t)k * 2048), h1 = *(const f32x4*)(sh + (size_t)k * 2048 + 4);
#pragma unroll
                for (int e = 0; e < 4; ++e) { hin[e] = a0[e] * hin[e] + h0[e]; hin[4 + e] = a1[e] * hin[4 + e] + h1[e]; } } }
#pragma unroll 4
        for (int rr = 0; rr < 16; ++rr) { const int r = 16 * rq + rr, row = c * 64 + r;
            if (smp && (rr & 7) == 0) { const int b = 8 * (c - 128) + (r >> 3); const float* st = inptr(F, I_SLH) + (size_t)(l * 128 + b) * 2048 + ch; const f32x4 s0 = *(const f32x4*)st, s1 = *(const f32x4*)(st + 4);
#pragma unroll
                for (int e = 0; e < 4; ++e) { hin[e] = s0[e]; hin[4 + e] = s1[e]; } }
            const size_t o = (size_t)row * 2048 + ch; const f32x4 l0 = *(const f32x4*)(HLOC + o), l1 = *(const f32x4*)(HLOC + o + 4), q0 = *(const f32x4*)(PCUM + o), q1 = *(const f32x4*)(PCUM + o + 4);
            const v4u vg = *(const v4u*)(PROJ + (size_t)row * INC + OFF_BG + ch); float bg[8], hv[8], ov[8]; UNPK8(vg, bg);
#pragma unroll
            for (int e = 0; e < 4; ++e) { hv[e] = l0[e] + q0[e] * hin[e]; hv[4 + e] = l1[e] + q1[e] * hin[4 + e]; }
#pragma unroll
            for (int e = 0; e < 8; ++e) ov[e] = hv[e] * silu(bg[e]);
            v4u wv; wv.x = pk2(ov[0], ov[1]); wv.y = pk2(ov[2], ov[3]); wv.z = pk2(ov[4], ov[5]); wv.w = pk2(ov[6], ov[7]); *(v4u*)(MIX + (size_t)row * DM + 1024 + ch) = wv;
            bool last; float* so;
            if (smp) { last = (rr & 7) == 7; so = F.out + O_SH + (size_t)(l * 128 + 8 * (c - 128) + (r >> 3)) * 2048 + ch; }
            else { last = ((c & 31) == 31) && r == 63; so = F.out + O_PH + (size_t)(l * 4 + (c >> 5)) * 2048 + ch; }
            if (last) { *(f32x4*)so = (f32x4){hv[0], hv[1], hv[2], hv[3]}; *(f32x4*)(so + 4) = (f32x4){hv[4], hv[5], hv[6], hv[7]}; } }
    }
}

template <int l> __device__ __forceinline__ void layer_program(const Frame& F, const XcdBarrier& bar, int lo, int hi) {
#define IN(k) (lo <= (k) && (k) < hi)
#define SEAM(k) do { if (IN(k) && IN((k) + 1)) xcd_barrier(bar); } while (0)
#define PHASE_FRAME() Frame Fp = F; Fp.ws = launder(F.ws); Fp.out = launder(F.out);
        const int pb = 2 + 5 * l;
        if (IN(pb)) { PHASE_FRAME()
            pg8::Gemm g{(const bf16*)(Fp.ws + WS_H), (const bf16*)(Fp.ws + WS_WINT) + (size_t)l * 10240 * 4096, MROWS, INC, DM}; pg8::StaticOrder S; S.init(MROWS, INC, F.G, (int)blockIdx.x);
            EpiProj E{(bf16*)(Fp.ws + WS_PROJ)};
            pg8::gemm_phase<EpiProj, pg8::StaticOrder, true, true>(F.lds + RING_OFF, g, S, E);
        }
        SEAM(pb);
        if (IN(pb + 1)) { PHASE_FRAME() s5_phase(Fp, l); b1_phase(Fp, l); mixa_phase(Fp, l); }
        SEAM(pb + 1);
        if (IN(pb + 2)) { PHASE_FRAME()
            if ((int)blockIdx.x < 144) {
                pg8::Gemm g{(const bf16*)(Fp.ws + WS_YG), (const bf16*)(Fp.ws + WS_WGLUT) + (size_t)l * 1024 * 1024, MROWS, 1024, 1024}; pg8::StaticOrder S; S.init(MROWS, 1024, 144, (int)blockIdx.x);
                EpiGlu E{(const bf16*)(Fp.ws + WS_YG), (const bf16*)(Fp.ws + WS_PROJ), inptr(Fp, I_BGLU) + l * 1024, (bf16*)(Fp.ws + WS_MIX)};
                pg8::gemm_phase<EpiGlu, pg8::StaticOrder, true, true>(F.lds + RING_OFF, g, S, E);
            } else b2_phase(Fp, l, 144);
        }
        SEAM(pb + 2);
        if (IN(pb + 3)) { PHASE_FRAME()
            float* X1 = (float*)(Fp.ws + WS_X1); const float* MOD = (const float*)(Fp.ws + WS_MOD);
            pg8::Gemm g{(const bf16*)(Fp.ws + WS_MIX), (const bf16*)(Fp.ws + WS_WOUTT) + (size_t)l * 4096 * 4096, MROWS, DM, DM}; pg8::StaticOrder S; S.init(MROWS, DM, F.G, (int)blockIdx.x);
            EpiResGate E{l == 0 ? inptr(Fp, I_XP) : X1, l == 0 ? inptr(Fp, I_XS) : X1 + (size_t)NPROMPT * DM, l == 0 ? X1 : Fp.out + O_Y, MOD + (size_t)l * NSEQ * MODW + 2 * DM};
            pg8::gemm_phase<EpiResGate, pg8::StaticOrder, true, true>(F.lds + RING_OFF, g, S, E);
        }
        SEAM(pb + 3);
        if (IN(pb + 4)) { PHASE_FRAME() float* X1 = (float*)(Fp.ws + WS_X1);
            if (l == 0) norm_phase(Fp, X1, X1 + (size_t)NPROMPT * DM, 0, 1); else norm_phase(Fp, Fp.out + O_Y, Fp.out + O_Y + (size_t)NPROMPT * DM, 1, 0); }
        SEAM(pb + 4);

#undef IN
#undef SEAM
#undef PHASE_FRAME
}
struct Args { const float* in[34]; float* out; unsigned char* ws; int ph_lo, ph_hi; };
__global__ void __launch_bounds__(NWAVES * 64, 2) mega_fwd(Args args) {
    extern __shared__ __attribute__((aligned(16))) unsigned char lds[];
    Frame F;
    F.lds = (LAS unsigned char*)lds; F.MISC = (volatile LAS unsigned*)(F.lds + MISC_OFF);
    F.tid = threadIdx.x; F.lane = F.tid & 63; F.wave = __builtin_amdgcn_readfirstlane(F.tid >> 6); F.G = gridDim.x;
    F.out = args.out; F.ws = args.ws; F.ctl = (gu32*)(args.ws + WS_CTL);
    if (F.tid < 128) ((LAS unsigned*)(F.lds + LDSCTL_OFF))[F.tid] = 0u;
    if (F.tid >= 128 && F.tid < 128 + 34) { const __attribute__((address_space(4))) unsigned long long* ka = (const __attribute__((address_space(4))) unsigned long long*)__builtin_amdgcn_kernarg_segment_ptr();
        ((LAS unsigned long long*)(F.lds + PTR_OFF))[F.tid - 128] = ka[F.tid - 128]; }
    __syncthreads();
    XcdBarrier bar; bar.bar = (unsigned*)(F.ctl + CW_BAR); bar.x = 0; bar.st = nullptr;
    if (N_LAUNCHES == 1) bar = xcd_barrier_post((unsigned*)(F.ctl + CW_BAR), F.MISC + 8);
    const int lo = args.ph_lo, hi = args.ph_hi;
#define IN(k) (lo <= (k) && (k) < hi)
#define SEAM(k) do { if (IN(k) && IN((k) + 1)) xcd_barrier(bar); } while (0)
#define PHASE_FRAME() Frame Fp = F; Fp.ws = launder(F.ws); Fp.out = launder(F.out);
    if (IN(0)) { PHASE_FRAME()
        for (int t = blockIdx.x; t < 256; t += F.G) adaln_task(Fp, t >> 7, t & 127);
        __syncthreads();
        p0_transposes(Fp);
        __syncthreads();
        for (int t = blockIdx.x; t < 128; t += F.G) s5_mats(Fp, t >> 6, t & 63);
    }
    SEAM(0);
    if (IN(1)) { PHASE_FRAME() norm_phase(Fp, inptr(Fp, I_XP), inptr(Fp, I_XS), 0, 0); }
    SEAM(1);
    layer_program<0>(F, bar, lo, hi);
    layer_program<1>(F, bar, lo, hi);
#undef IN
#undef SEAM
}

extern "C" void kernel_launch(void* const* d_in, const int* in_sizes, int n_in, void* d_out, int out_size, void* d_ws, size_t ws_size, hipStream_t stream) {
    static int grid = 0;
    if (grid == 0) {
        if (n_in != 34 || out_size != (int)O_END || ws_size < WS_END) { fprintf(stderr, "kernel_launch: unexpected shapes: n_in %d out %d ws %zu\n", n_in, out_size, ws_size); grid = -1; return; }
        int dev = 0, cus = 0, per_cu = 0;
        if (hipGetDevice(&dev) != hipSuccess || hipDeviceGetAttribute(&cus, hipDeviceAttributeMultiprocessorCount, dev) != hipSuccess) { grid = -1; return; }
        if (hipFuncSetAttribute((const void*)mega_fwd, hipFuncAttributeMaxDynamicSharedMemorySize, LDS_BYTES) != hipSuccess) { fprintf(stderr, "kernel_launch: hipFuncSetAttribute failed\n"); grid = -1; return; }
        if (hipOccupancyMaxActiveBlocksPerMultiprocessor(&per_cu, (const void*)mega_fwd, NWAVES * 64, LDS_BYTES) != hipSuccess || per_cu < 1)
            fprintf(stderr, "kernel_launch: occupancy query reports %d workgroups per CU\n", per_cu);
        (void)hipGetLastError();
        grid = cus < 256 ? cus : 256;
    }
    if (grid < 0) return;
    if (hipMemsetAsync((char*)d_ws + WS_CTL, 0, CTL_ZERO_BYTES, stream) != hipSuccess) { fprintf(stderr, "kernel_launch: memset failed\n"); return; }
    Args a{};
    for (int i = 0; i < 34; ++i) a.in[i] = (const float*)d_in[i];
    a.out = (float*)d_out; a.ws = (unsigned char*)d_ws;
    if (N_LAUNCHES == 1) { a.ph_lo = 0; a.ph_hi = N_PHASES; hipLaunchKernelGGL(mega_fwd, dim3(grid), dim3(NWAVES * 64), LDS_BYTES, stream, a); }
    else for (int p = 0; p < N_PHASES; ++p) { a.ph_lo = p; a.ph_hi = p + 1; hipLaunchKernelGGL(mega_fwd, dim3(grid), dim3(NWAVES * 64), LDS_BYTES, stream, a); }
    const hipError_t le = hipPeekAtLastError();
    if (le != hipSuccess) fprintf(stderr, "kernel_launch: launch failed: %s\n", hipGetErrorName(le));
}
```

```cpp
#include <hip/hip_runtime.h>
#include <cstdio>
#include <cstdint>
#include <hip/hip_runtime.h>
#include <cstdio>
#include <cstdint>
namespace pg8 {
#define PG8_LAS __attribute__((address_space(3)))
typedef unsigned short bf16_t;
typedef short bf16x8 __attribute__((ext_vector_type(8)));
typedef float f32x4 __attribute__((ext_vector_type(4)));
typedef unsigned u32x4 __attribute__((ext_vector_type(4)));
constexpr int BM = 256, BK = 64, HALF = 128, HTB = HALF * BK * 2  , STAGE_BYTES = 8 * HTB, NXCD = 8, WGM = 8;

__host__ __device__ __forceinline__ int lds_byte(int r, int c) { const int st = (r >> 4) * 2 + (c >> 5), rr = r & 15, cc = c & 31, ob = rr * 64 + cc * 2; return st * 1024 + (ob ^ (((ob >> 9) & 1) << 5)); }
__host__ __device__ __forceinline__ void stage_rc(int b, int& R, int& C) { const int st = b / 1024, sb = b % 1024, swz = sb ^ (((sb >> 9) & 1) << 5); R = (st >> 1) * 16 + swz / 64; C = (st & 1) * 32 + (swz % 64) / 2; }
__host__ __device__ __forceinline__ int perm32(int rho) { const int n = rho >> 4, i = rho & 15; return 8 * (i >> 2) + 4 * n + (i & 3); }

struct Unit { int pm, pn, kt0, nkt; };
struct Gemm { const bf16_t* A; const bf16_t* Bt; int M, N, K; };

struct StaticOrder {
    int nM, nN, nwg, G, c, nkt;
    __host__ __device__ void init(int M, int N, int G_, int c_, int K_) { nM = M / BM; nN = N / BM; nwg = nM * nN; G = G_; c = c_; nkt = K_ / BK; }
    __host__ __device__ bool next(int i, Unit& u) const {
        const long L = (long)i * G + c; if (L >= nwg) return false;
        int wgid = (int)L; { const int q = nwg / NXCD, r = nwg % NXCD, xcd = wgid % NXCD, off = wgid / NXCD; wgid = (xcd < r ? xcd * (q + 1) : r * (q + 1) + (xcd - r) * q) + off; }
        const int nig = WGM * nN, gid = wgid / nig, fm = gid * WGM, gsz = (nM - fm) < WGM ? (nM - fm) : WGM;
        u.pm = fm + ((wgid % nig) % gsz); u.pn = (wgid % nig) / gsz; u.kt0 = 0; u.nkt = nkt; return true;
    }
    __device__ __forceinline__ void a_ready(const Unit&) const {}
    __device__ __forceinline__ void done(const Unit&) const {}
};

__device__ __forceinline__ unsigned cvt_pk_bf16(float lo, float hi) { unsigned r; asm volatile("v_cvt_pk_bf16_f32 %0, %1, %2" : "=v"(r) : "v"(lo), "v"(hi)); return r; }
template <class Epi, class Sched, bool ALIGN_EPI = false, bool SP2 = false>
__device__ __forceinline__ void gemm_phase(PG8_LAS unsigned char* lds, const Gemm g, const Sched& S, const Epi& E) {
    const int tid = threadIdx.x, wid = __builtin_amdgcn_readfirstlane(tid >> 6), lane = tid & 63, wr = wid >> 2, wc = wid & 3, fr = lane & 15, fq = lane >> 4;
    const int K = g.K;
    unsigned voffA[2], voffB[2];
#pragma unroll
    for (int i = 0; i < 2; ++i) { int R, C; stage_rc(tid * 16 + i * 8192, R, C); const int Rb = Epi::PERM ? ((R & ~31) + perm32(R & 31)) : R;
        voffA[i] = (unsigned)(R * K + C) * 2u; voffB[i] = (unsigned)(Rb * K + C) * 2u; }
    const size_t kstep = (size_t)(BK * 2);
    const size_t hstep = (size_t)HALF * K * 2;
    const size_t tstep = 2 * hstep;
    const unsigned ldsw = (unsigned)wid * 1024u;
    const int aoff = lds_byte(wr * 64 + fr, fq * 8), boff = lds_byte(wc * 32 + fr, fq * 8);
#define PG8_SA(b, h) (((b) * 2 + (h)) * HTB)
#define PG8_SB(b, h) ((4 + (b) * 2 + (h)) * HTB)
#define PG8_STAGE(bufoff, gbase, voff) do { _Pragma("unroll") for (int _i = 0; _i < 2; ++_i) \
        __builtin_amdgcn_global_load_lds((const unsigned*)((const char*)(gbase) + (voff)[_i]), (PG8_LAS unsigned*)(lds + (bufoff) + ldsw + _i * 8192), 16, 0, 0); } while (0)
#define PG8_LDA(dst, b, h) do { _Pragma("unroll") for (int m = 0; m < 4; ++m) _Pragma("unroll") for (int k = 0; k < 2; ++k) dst[m][k] = *(const PG8_LAS bf16x8*)(lds + PG8_SA(b, h) + aoff + m * 2048 + k * 1024); } while (0)
#define PG8_LDB(dst, b, h) do { _Pragma("unroll") for (int n = 0; n < 2; ++n) _Pragma("unroll") for (int k = 0; k < 2; ++k) dst[n][k] = *(const PG8_LAS bf16x8*)(lds + PG8_SB(b, h) + boff + n * 2048 + k * 1024); } while (0)
#define PG8_MMA(ai, bj, At, Bt) do { __builtin_amdgcn_s_setprio(1); _Pragma("unroll") for (int m = 0; m < 4; ++m) _Pragma("unroll") for (int n = 0; n < 2; ++n) _Pragma("unroll") for (int k = 0; k < 2; ++k) \
        acc[ai][bj][m][n] = __builtin_amdgcn_mfma_f32_16x16x32_bf16(Bt[n][k], At[m][k], acc[ai][bj][m][n], 0, 0, 0); __builtin_amdgcn_s_setprio(0); } while (0)
#define PG8_WAIT_V(n) asm volatile("s_waitcnt vmcnt(" #n ")" ::: "memory")
#define PG8_WAIT_L(n) asm volatile("s_waitcnt lgkmcnt(" #n ")" ::: "memory")
#define PG8_BAR __builtin_amdgcn_s_barrier()
#define PG8_SCHED __builtin_amdgcn_sched_barrier(0)
    Unit cur, nxt; int ui = 0;
    if (!S.next(0, cur)) return;
    f32x4 acc[2][2][4][2];
#pragma unroll
    for (int a = 0; a < 2; ++a)
#pragma unroll
        for (int b = 0; b < 2; ++b)
#pragma unroll
            for (int m = 0; m < 4; ++m)
#pragma unroll
                for (int n = 0; n < 2; ++n) acc[a][b][m][n] = (f32x4){0.f, 0.f, 0.f, 0.f};
    bf16x8 At[4][2], B0[2][2], B1[2][2];
    const char* cA = (const char*)g.A + (size_t)cur.pm * tstep + (size_t)cur.kt0 * kstep; const char* cB = (const char*)g.Bt + (size_t)cur.pn * tstep + (size_t)cur.kt0 * kstep;
    S.a_ready(cur);
    if constexpr (SP2) {
        PG8_STAGE(PG8_SB(0, 0), cB, voffB); PG8_STAGE(PG8_SB(0, 1), cB + hstep, voffB); PG8_STAGE(PG8_SA(0, 0), cA, voffA); PG8_STAGE(PG8_SA(0, 1), cA + hstep, voffA);
        if (wr == 1) PG8_BAR;
        PG8_WAIT_V(2); PG8_BAR;
        PG8_STAGE(PG8_SB(1, 0), cB + kstep, voffB); PG8_STAGE(PG8_SA(1, 0), cA + kstep, voffA); PG8_STAGE(PG8_SB(1, 1), cB + hstep + kstep, voffB);
        PG8_WAIT_V(6); PG8_BAR;
    } else {
        PG8_STAGE(PG8_SB(0, 0), cB, voffB); PG8_STAGE(PG8_SA(0, 0), cA, voffA); PG8_STAGE(PG8_SB(0, 1), cB + hstep, voffB); PG8_STAGE(PG8_SA(0, 1), cA + hstep, voffA);
        if (wr == 1) PG8_BAR;
        PG8_WAIT_V(4); PG8_BAR;
        PG8_STAGE(PG8_SB(1, 0), cB + kstep, voffB); PG8_STAGE(PG8_SA(1, 0), cA + kstep, voffA); PG8_STAGE(PG8_SB(1, 1), cB + hstep + kstep, voffB);
        PG8_WAIT_V(6); PG8_BAR;
    }
    for (;;) {
        const bool has_next = S.next(ui + 1, nxt);
        const char* nA = has_next ? (const char*)g.A + (size_t)nxt.pm * tstep + (size_t)nxt.kt0 * kstep : cA; const char* nB = has_next ? (const char*)g.Bt + (size_t)nxt.pn * tstep + (size_t)nxt.kt0 * kstep : cB;
        const int nt = cur.nkt;
        for (int t = 0; t < nt; t += 2) {
            const bool last = (t == nt - 2);
            const char* a1 = cA + (size_t)(t + 1) * kstep;
            const char* a2 = last ? nA : cA + (size_t)(t + 2) * kstep; const char* b2 = last ? nB : cB + (size_t)(t + 2) * kstep;
            const char* a3 = a2 + kstep; const char* b3 = b2 + kstep;
            if (last && has_next) S.a_ready(nxt);
            if constexpr (SP2) {
            PG8_LDB(B0, 0, 0); PG8_LDB(B1, 0, 1); PG8_SCHED; PG8_LDA(At, 0, 0); PG8_STAGE(PG8_SA(1, 1), a1 + hstep, voffA);
            PG8_WAIT_V(8); PG8_WAIT_L(0); PG8_BAR; PG8_MMA(0, 0, At, B0); PG8_MMA(0, 1, At, B1); PG8_BAR; PG8_SCHED;
            PG8_LDA(At, 0, 1); PG8_STAGE(PG8_SB(0, 0), b2, voffB); PG8_STAGE(PG8_SB(0, 1), b2 + hstep, voffB); PG8_STAGE(PG8_SA(0, 0), a2, voffA);
            PG8_WAIT_V(8); PG8_WAIT_L(0); PG8_BAR; PG8_MMA(1, 0, At, B0); PG8_MMA(1, 1, At, B1); PG8_BAR; PG8_SCHED;
            PG8_LDB(B0, 1, 0); PG8_LDB(B1, 1, 1); PG8_SCHED; PG8_LDA(At, 1, 0); PG8_STAGE(PG8_SA(0, 1), a2 + hstep, voffA);
            PG8_WAIT_V(8); PG8_WAIT_L(0); PG8_BAR; PG8_MMA(0, 0, At, B0); PG8_MMA(0, 1, At, B1); PG8_BAR; PG8_SCHED;
            PG8_LDA(At, 1, 1); PG8_STAGE(PG8_SB(1, 0), b3, voffB); PG8_STAGE(PG8_SB(1, 1), b3 + hstep, voffB); PG8_STAGE(PG8_SA(1, 0), a3, voffA);
            PG8_WAIT_V(8); PG8_WAIT_L(0); PG8_BAR; PG8_MMA(1, 0, At, B0); PG8_MMA(1, 1, At, B1); PG8_BAR; PG8_SCHED;
            } else {
            PG8_LDB(B0, 0, 0); PG8_SCHED; PG8_LDA(At, 0, 0); PG8_STAGE(PG8_SA(1, 1), a1 + hstep, voffA);
            PG8_WAIT_L(8); PG8_BAR; PG8_WAIT_L(0); PG8_MMA(0, 0, At, B0); PG8_BAR; PG8_SCHED;
            PG8_LDB(B1, 0, 1); PG8_STAGE(PG8_SB(0, 0), b2, voffB);
            PG8_BAR; PG8_WAIT_L(0); PG8_MMA(0, 1, At, B1); PG8_BAR;
            PG8_LDA(At, 0, 1); PG8_STAGE(PG8_SA(0, 0), a2, voffA);
            PG8_BAR; PG8_WAIT_L(0); PG8_MMA(1, 0, At, B0); PG8_BAR; PG8_SCHED;
            PG8_STAGE(PG8_SB(0, 1), b2 + hstep, voffB);
            PG8_WAIT_V(6); PG8_BAR; PG8_MMA(1, 1, At, B1); PG8_BAR;
            PG8_LDB(B0, 1, 0); PG8_SCHED; PG8_LDA(At, 1, 0); PG8_STAGE(PG8_SA(0, 1), a2 + hstep, voffA);
            PG8_WAIT_L(8); PG8_BAR; PG8_WAIT_L(0); PG8_MMA(0, 0, At, B0); PG8_BAR; PG8_SCHED;
            PG8_LDB(B1, 1, 1); PG8_STAGE(PG8_SB(1, 0), b3, voffB);
            PG8_BAR; PG8_WAIT_L(0); PG8_MMA(0, 1, At, B1); PG8_BAR;
            PG8_LDA(At, 1, 1); PG8_STAGE(PG8_SA(1, 0), a3, voffA);
            PG8_BAR; PG8_WAIT_L(0); PG8_MMA(1, 0, At, B0); PG8_BAR; PG8_SCHED;
            PG8_STAGE(PG8_SB(1, 1), b3 + hstep, voffB);
            PG8_WAIT_V(6); PG8_BAR; PG8_MMA(1, 1, At, B1); PG8_BAR;
            }
        }
        if constexpr (ALIGN_EPI) { if (wr == 0) PG8_BAR; }
        if constexpr (!Epi::AFTER_DRAIN) { E(acc, cur, wr, wc, fr, fq); S.done(cur); }
        if (!has_next) break;
#pragma unroll
        for (int a = 0; a < 2; ++a)
#pragma unroll
            for (int b = 0; b < 2; ++b)
#pragma unroll
                for (int m = 0; m < 4; ++m)
#pragma unroll
                    for (int n = 0; n < 2; ++n) acc[a][b][m][n] = (f32x4){0.f, 0.f, 0.f, 0.f};
        cur = nxt; cA = nA; cB = nB; ++ui;
        if constexpr (ALIGN_EPI) { if (wr == 1) PG8_BAR; }
    }
    PG8_WAIT_V(0);
    if constexpr (!ALIGN_EPI) { if (wr == 0) PG8_BAR; }
    PG8_BAR;
    if constexpr (Epi::AFTER_DRAIN) { E.fused(acc, cur, wr, wc, fr, fq, lds, wid, lane); S.done(cur); }
#undef PG8_SA
#undef PG8_SB
#undef PG8_STAGE
#undef PG8_LDA
#undef PG8_LDB
#undef PG8_MMA
#undef PG8_WAIT_V
#undef PG8_WAIT_L
#undef PG8_BAR
#undef PG8_SCHED
}
}
#define GAS __attribute__((address_space(1)))
#define LAS __attribute__((address_space(3)))
typedef unsigned short bf16;
typedef unsigned v4u __attribute__((ext_vector_type(4)));
typedef float f32x4 __attribute__((ext_vector_type(4)));
typedef short bf16x8 __attribute__((ext_vector_type(8)));
typedef GAS unsigned gu32;
typedef GAS unsigned long long gu64;
#define RLX_AGENT __ATOMIC_RELAXED, __HIP_MEMORY_SCOPE_AGENT
#define LDS_WAIT() asm volatile("s_waitcnt lgkmcnt(0)" ::: "memory")
#define VM_WAIT() asm volatile("s_waitcnt vmcnt(0)" ::: "memory")
__device__ __forceinline__ unsigned long long rt() { return __builtin_amdgcn_s_memrealtime(); }
typedef float f32x2_t __attribute__((ext_vector_type(2))); typedef __bf16 bf16x2_t __attribute__((ext_vector_type(2)));
__device__ __forceinline__ unsigned pk2(float lo, float hi) { const f32x2_t v = {lo, hi}; return __builtin_bit_cast(unsigned, __builtin_convertvector(v, bf16x2_t)); }
__device__ __forceinline__ unsigned f2bf(float f) { return pk2(f, 0.f) & 0xffffu; }

#define XB_TMO      128
#define XB_XCNT(j)  (256  + 64 * (j))
#define XB_XSUB(j)  (1280 + 64 * (j))
#define XB_XGEN(j)  (2304 + 64 * (j))
#define XB_TOP      3328
#define XB_TOPGEN   3392
#define XCD_BAR_WORDS 3456
#define XB_SPIN_CAP (1u << 18)

__device__ __forceinline__ unsigned xb_ld(unsigned* p)              { return __hip_atomic_load(p, __ATOMIC_RELAXED, __HIP_MEMORY_SCOPE_AGENT); }
__device__ __forceinline__ unsigned xb_add(unsigned* p, unsigned v) { return __hip_atomic_fetch_add(p, v, __ATOMIC_RELAXED, __HIP_MEMORY_SCOPE_AGENT); }
__device__ __forceinline__ unsigned xb_xcc_id() { return (unsigned)__builtin_amdgcn_s_getreg((3 << 11) | 20) & 0xFu; }
#define XB_SPIN(cond, bar) do { unsigned _sp = 0; while (cond) { __builtin_amdgcn_s_sleep(1); \
    if ((++_sp & 255u) == 0u) { if (xb_ld(&(bar)[XB_TMO])) break; if (_sp > XB_SPIN_CAP) { atomicAdd(&(bar)[XB_TMO], 1u); break; } } } } while (0)

struct XcdBarrier {
    unsigned* bar; unsigned x;
    volatile LAS unsigned* st;
};

__device__ __forceinline__ XcdBarrier xcd_barrier_post(unsigned* bar, volatile LAS unsigned* st) {
    XcdBarrier b; b.bar = bar; b.x = xb_xcc_id(); b.st = st;
    if (threadIdx.x == 0) (void)xb_add(&bar[XB_XCNT(b.x)], 1u);
    return b;
}
__device__ __forceinline__ void xcd_barrier_complete(unsigned* bar, unsigned x, unsigned& nloc, unsigned& nx) {
    const unsigned G = gridDim.x * gridDim.y * gridDim.z;
    unsigned sum, cnt, mine, sp = 0u;
    for (;;) {
        sum = 0u; cnt = 0u; mine = 0u;
#pragma unroll
        for (unsigned j = 0; j < 16; ++j) { const unsigned c = xb_ld(&bar[XB_XCNT(j)]); sum += c; cnt += (c > 0u) ? 1u : 0u; mine = (j == x) ? c : mine; }
        if (sum == G) break;
        __builtin_amdgcn_s_sleep(1);
        if ((++sp & 255u) == 0u) { if (xb_ld(&bar[XB_TMO])) break; if (sp > XB_SPIN_CAP) { atomicAdd(&bar[XB_TMO], 1u); break; } }
    }
    nloc = mine > 0u ? mine : 1u; nx = cnt > 0u ? cnt : 1u;
}

__device__ __forceinline__ void xcd_barrier(const XcdBarrier& b) {
    asm volatile("s_waitcnt vmcnt(0)" ::: "memory");
    __syncthreads();
    if (threadIdx.x == 0) {
        GAS unsigned* gbar_ = (GAS unsigned*)b.bar; asm volatile("" : "+s"(gbar_)); unsigned* bar = (unsigned*)gbar_;
        __builtin_amdgcn_s_waitcnt(0);
        unsigned nloc = b.st[0], nx = b.st[1];
        if (nloc == 0u) { unsigned bx = b.x; asm volatile("" : "+s"(bx)); xcd_barrier_complete(bar, bx, nloc, nx); b.st[0] = nloc; b.st[1] = nx; }
        const unsigned old = xb_add(&bar[XB_XSUB(b.x)], 1u);
        const unsigned gen = old / nloc;
        if (old + 1u == (gen + 1u) * nloc) {
            __builtin_amdgcn_fence(__ATOMIC_RELEASE, "agent");
            asm volatile("s_waitcnt vmcnt(0)" ::: "memory");
            const unsigned og = xb_add(&bar[XB_TOP], 1u);
            const unsigned tg = og / nx;
            if (og + 1u == (tg + 1u) * nx) xb_add(&bar[XB_TOPGEN], 1u);
            else XB_SPIN(xb_ld(&bar[XB_TOPGEN]) == tg, bar);
            __builtin_amdgcn_fence(__ATOMIC_ACQUIRE, "agent");
            xb_add(&bar[XB_XGEN(b.x)], 1u);
            asm volatile("s_waitcnt vmcnt(0)" ::: "memory");
        } else {
            XB_SPIN(xb_ld(&bar[XB_XGEN(b.x)]) == gen, bar);
            __builtin_amdgcn_fence(__ATOMIC_ACQUIRE, "agent");
            asm volatile("s_waitcnt vmcnt(0)" ::: "memory");
        }
    }
    __syncthreads();
}

constexpr int NWAVES = 8;
#ifndef MK_N_LAUNCHES
#define MK_N_LAUNCHES 1
#endif
constexpr int N_PHASES = 12;
#ifndef GEMM1_ALIGN
#define GEMM1_ALIGN false
#endif
#ifndef GEMM1_SP2
#define GEMM1_SP2 true
#endif
#ifndef PROBE_DUP
#define PROBE_DUP 0
#define PROBE_ADA 0
#endif

constexpr int N_LAUNCHES = MK_N_LAUNCHES;

constexpr int DM = 4096, MROWS = 9216, NPROMPT = 8192, NSEQ = 132, INC = 10240, MODW = 12288;
constexpr int OFF_AB = 0, OFF_AC = 1024, OFF_AX = 2048, OFF_AG = 3072, OFF_BX = 4096, OFF_BG = 6144, OFF_CU = 8192, OFF_CG = 9216;
constexpr float RMS_EPS = 1e-6f;
constexpr size_t O_Y = 0;
constexpr size_t O_PCA = (size_t)MROWS * DM;
constexpr size_t O_PCB = O_PCA + 2 * 4 * 2 * 1024;
constexpr size_t O_PH  = O_PCB + 2 * 4 * 3 * 2048;
constexpr size_t O_PRE = O_PH + 2 * 4 * 2048;
constexpr size_t O_PIM = O_PRE + 2 * 4 * 4096;
constexpr size_t O_SCA = O_PIM + 2 * 4 * 4096;
constexpr size_t O_SCB = O_SCA + 2 * 128 * 2 * 1024;
constexpr size_t O_SH  = O_SCB + 2 * 128 * 3 * 2048;
constexpr size_t O_SRE = O_SH + 2 * 128 * 2048;
constexpr size_t O_SIM = O_SRE + 2 * 128 * 4096;
constexpr size_t O_END = O_SIM + 2 * 128 * 4096;
static_assert(O_END == 42614784, "output size");
constexpr size_t MiB = 1u << 20;
constexpr size_t WS_CTL = 0, CTL_ZERO_BYTES = 1 * MiB;
constexpr size_t WS_WOUTT = 162 * MiB;
constexpr size_t WS_WGLUT = 226 * MiB;
constexpr size_t WS_WRGT = 230 * MiB;
constexpr size_t WS_WIGT = 231 * MiB;
constexpr size_t WS_S5M = 232 * MiB, S5M_STRIDE = 131072;
constexpr size_t WS_MOD = 248 * MiB;
constexpr size_t WS_H = 262 * MiB;
constexpr size_t WS_PROJ = 334 * MiB;
constexpr size_t WS_MIX = 514 * MiB;
constexpr size_t WS_X1 = 586 * MiB;
constexpr size_t WS_YG = 730 * MiB;
constexpr size_t WS_HLOC = 748 * MiB;
constexpr size_t WS_PCUM = 820 * MiB;
constexpr size_t WS_SUMA = 892 * MiB, WS_SUMH = 893 * MiB;
constexpr int LDK = 4160;
constexpr size_t WS_HP = 894 * MiB;
constexpr size_t WS_WINTP = 968 * MiB;
constexpr size_t WS_CBF = 1132 * MiB;
constexpr size_t WS_END = 1134 * MiB;
constexpr int CW_BAR = 4096;
constexpr int RING_OFF = 0;
constexpr int LDS_BYTES = 147456;
constexpr int LDSCTL_OFF = LDS_BYTES - 1024, MISC_OFF = LDSCTL_OFF + 320, PTR_OFF = LDSCTL_OFF + 512;

typedef unsigned u32x2 __attribute__((ext_vector_type(2)));
__device__ __forceinline__ float bflo(unsigned u) { return __builtin_bit_cast(float, u << 16); }
__device__ __forceinline__ float bfhi(unsigned u) { return __builtin_bit_cast(float, u & 0xffff0000u); }
__device__ __forceinline__ float fexp(float x) { return __builtin_amdgcn_exp2f(x * 1.4426950408889634f); }
__device__ __forceinline__ float sigm(float x) { return __builtin_amdgcn_rcpf(1.0f + __builtin_amdgcn_exp2f(x * -1.4426950408889634f)); }
__device__ __forceinline__ float silu(float x) { return x * sigm(x); }
__device__ __forceinline__ float gelu_tanh(float x) { return x * sigm(1.5957691216f * (x + 0.044715f * x * x * x)); }
#define UNPK8(v, f) do { f[0] = bflo((v).x); f[1] = bfhi((v).x); f[2] = bflo((v).y); f[3] = bfhi((v).y); f[4] = bflo((v).z); f[5] = bfhi((v).z); f[6] = bflo((v).w); f[7] = bfhi((v).w); } while (0)

struct Frame {
    LAS unsigned char* lds;
    volatile LAS unsigned* MISC;
    gu32* ctl;
    int tid, lane, wave, G;
    float* out;
    unsigned char* ws;
};
enum { I_XP = 0, I_XS, I_CP, I_CS, I_SCA, I_SCB, I_SLH, I_SRE, I_SIM, I_GN, I_WADA, I_BADA, I_WIN, I_WCA, I_BCA, I_WCB, I_BCB, I_WRG, I_BRG, I_WIG, I_BIG,
       I_LAM, I_S5LR, I_S5LI, I_S5DT, I_S5BR, I_S5BI, I_S5CR, I_S5CI, I_S5D, I_WGLU, I_BGLU, I_WOUT, I_GFIN };

template <class T> __device__ __forceinline__ T* launder(T* p) { GAS T* g = (GAS T*)p; asm volatile("" : "+s"(g)); return (T*)g; }
__device__ __forceinline__ const float* inptr(const Frame& F, int i) {
    volatile LAS unsigned* t = (volatile LAS unsigned*)(F.lds + PTR_OFF);
    const unsigned lo = __builtin_amdgcn_readfirstlane(t[2 * i]), hi = __builtin_amdgcn_readfirstlane(t[2 * i + 1]);
    const GAS float* g = (const GAS float*)(((unsigned long long)hi << 32) | (unsigned long long)lo); return (const float*)g;
}
__device__ __forceinline__ float wave_sum(float v) {
#pragma unroll
    for (int o = 1; o < 64; o <<= 1) v += __shfl_xor(v, o);
    return v;
}
__device__ __forceinline__ int seq_of_row(int row) { return row < NPROMPT ? (row >> 11) : 4 + ((row - NPROMPT) >> 3); }

constexpr int TR_IN_TILES = 64 * 160, TR_OUT_TILES = 64 * 64, TR_SMALL_TILES = 16 * 16 + 64 + 64;
struct TrTile { const float* src; bf16* dst; int N, K; };
__device__ __forceinline__ TrTile tr_locate(const Frame& F, int l, int which, int t) {
    const float* W; bf16* WT; int K, N; int r = t; bool found = false;
    W = nullptr; WT = nullptr; K = 128; N = 128;
    if (which & 1) { if (r < TR_IN_TILES) { W = inptr(F, I_WIN) + (size_t)l * 4096 * 10240; WT = (bf16*)(F.ws + WS_WINTP) + (size_t)l * 10240 * LDK; K = LDK; N = 10240; found = true; } else r -= TR_IN_TILES; }
    if (!found && (which & 2)) { if (r < TR_OUT_TILES) { W = inptr(F, I_WOUT) + (size_t)l * 4096 * 4096; WT = (bf16*)(F.ws + WS_WOUTT) + (size_t)l * 4096 * 4096; K = 4096; N = 4096; found = true; } else r -= TR_OUT_TILES; }
    if (!found) {
        if (r < 256) { W = inptr(F, I_WGLU) + (size_t)l * 1024 * 1024; WT = (bf16*)(F.ws + WS_WGLUT) + (size_t)l * 1024 * 1024; K = 1024; N = 1024; }
        else { r -= 256; const bool ig = r >= 64; if (ig) r -= 64; const int hd = r >> 2; r &= 3;
            W = inptr(F, ig ? I_WIG : I_WRG) + (size_t)(l * 16 + hd) * 16384; WT = (bf16*)(F.ws + (ig ? WS_WIGT : WS_WRGT)) + (size_t)(l * 16 + hd) * 16384; K = 128; N = 128; } }
    const int nblk = N >> 6, kb = r / nblk, nb = r - kb * nblk;
    int drow = 64 * nb;
    if (N == INC && nb < 64) { const int seg = nb >> 4, t = nb & 15; drow = t * 256 + (seg == 0 ? 1 : (seg == 1 ? 0 : seg)) * 64; }
    TrTile o; o.src = W + (size_t)(64 * kb) * N + 64 * nb; o.dst = WT + (size_t)drow * K + 64 * kb; o.N = N; o.K = K; return o;
}
#define TR_LOAD(v, tl) do { const float* s_ = (tl).src + (size_t)(lane >> 4) * (tl).N + 4 * (lane & 15); \
    _Pragma("unroll") for (int i = 0; i < 16; ++i) v[i] = __builtin_nontemporal_load((const f32x4*)(s_ + (size_t)(4 * i) * (tl).N)); } while (0)
#define TR_PROC(v, tl) do { \
    _Pragma("unroll") for (int i = 0; i < 16; ++i) { LAS float* d_ = T + (4 * i + (lane >> 4)) * 65 + 4 * (lane & 15); d_[0] = v[i].x; d_[1] = v[i].y; d_[2] = v[i].z; d_[3] = v[i].w; } \
    LDS_WAIT(); asm volatile("" ::: "memory"); \
    _Pragma("unroll") for (int j = 0; j < 8; ++j) { const int n_ = (lane >> 3) + 8 * j; const LAS float* s_ = T + (8 * (lane & 7)) * 65 + n_; \
        v4u o_; o_.x = pk2(s_[0], s_[65]); o_.y = pk2(s_[130], s_[195]); o_.z = pk2(s_[260], s_[325]); o_.w = pk2(s_[390], s_[455]); \
        __builtin_nontemporal_store(o_, (v4u*)((tl).dst + (size_t)n_ * (tl).K + 8 * (lane & 7))); } \
    LDS_WAIT(); asm volatile("" ::: "memory"); } while (0)
__device__ __forceinline__ void tr_run(const Frame& F, int l, int which, int widx, int wcnt) {
    const int total = ((which & 1) ? TR_IN_TILES : 0) + ((which & 2) ? TR_OUT_TILES : 0) + ((which & 4) ? TR_SMALL_TILES : 0); const int lane = F.lane;
    LAS float* T = (LAS float*)(F.lds + F.wave * 16640);
    int t = widx; if (t >= total) return;
    f32x4 va[16], vb[16];
    TrTile ta = tr_locate(F, l, which, t), tb = ta;
    TR_LOAD(va, ta);
    for (;;) {
        bool nx = (t + wcnt) < total;
        tb = tr_locate(F, l, which, nx ? t + wcnt : t); TR_LOAD(vb, tb);
        TR_PROC(va, ta);
        if (!nx) break;
        t += wcnt; nx = (t + wcnt) < total;
        ta = tr_locate(F, l, which, nx ? t + wcnt : t); TR_LOAD(va, ta);
        TR_PROC(vb, tb);
        if (!nx) break;
        t += wcnt;
    }
}

template <int PM> __device__ __forceinline__ void adaln_task_t(const Frame& F, int l, int cb) {
    const int tid = F.tid, lane = F.lane, w = F.wave, fr = lane & 15, fq = lane >> 4;
    constexpr int ABUF = (144 + 96) * 72;
    LAS bf16* L0 = (LAS bf16*)(F.lds);
    const float* W = inptr(F, I_WADA) + (size_t)l * 4096 * MODW + cb * 96;
    f32x4 acc[9]; const int ntg = w & 1, mg = w >> 1, mt0 = mg == 0 ? 0 : 1 + 2 * mg;
#pragma unroll
    for (int j = 0; j < 9; ++j) acc[j] = (f32x4){0.f, 0.f, 0.f, 0.f};
    f32x4 wv[4][4]; v4u cv[4][3];
    unsigned woff[2];
#pragma unroll
    for (int i = 0; i < 2; ++i) { const int task0 = tid + 512 * i, task = task0 < 768 ? task0 : 767, kp = task / 24, n4 = task % 24; woff[i] = (unsigned)((2 * kp) * MODW + 4 * n4); }
    const bf16* CB = (const bf16*)(F.ws + WS_CBF); unsigned coff[3];
#pragma unroll
    for (int i = 0; i < 3; ++i) { const int p0 = tid + 512 * i, p = p0 < 1152 ? p0 : 1151; coff[i] = (unsigned)(8 * p); }
#define ADA_LOADW(s, kt) do { const int kc_ = (kt) < 64 ? (kt) : 63; const float* wb_ = W + (size_t)kc_ * 64 * MODW; \
    wv[s][0] = *(const f32x4*)(wb_ + woff[0]); wv[s][1] = *(const f32x4*)(wb_ + woff[0] + MODW); \
    wv[s][2] = *(const f32x4*)(wb_ + woff[1]); wv[s][3] = *(const f32x4*)(wb_ + woff[1] + MODW); } while (0)
#define ADA_LOADC(s, kt) do { const int kc_ = (kt) < 64 ? (kt) : 63; \
    _Pragma("unroll") for (int i = 0; i < 3; ++i) cv[s][i] = *(const v4u*)(CB + kc_ * 9216 + coff[i]); } while (0)
#define ADA_WB(s, i) do { const int task = tid + 512 * (i), kp = task / 24, n4 = task % 24; LAS unsigned* bd_ = (LAS unsigned*)Bs + (4 * n4) * 36 + ((((kp >> 2) ^ (n4 >> 1)) & 7) << 2) + (kp & 3); \
    bd_[0] = pk2(wv[s][2 * (i)].x, wv[s][2 * (i) + 1].x); bd_[36] = pk2(wv[s][2 * (i)].y, wv[s][2 * (i) + 1].y); bd_[72] = pk2(wv[s][2 * (i)].z, wv[s][2 * (i) + 1].z); bd_[108] = pk2(wv[s][2 * (i)].w, wv[s][2 * (i) + 1].w); } while (0)
#define ADA_WRITE(s, kt) do { LAS bf16* As = L0 + ((kt) & 1) * ABUF; LAS bf16* Bs = As + 144 * 72; \
    ADA_WB(s, 0); if (tid < 256) ADA_WB(s, 1); \
    _Pragma("unroll") for (int i = 0; i < 3; ++i) { const int p = tid + 512 * i; if (p < 1152) *(LAS v4u*)(As + (p >> 3) * 72 + 8 * (p & 7)) = cv[s][i]; } } while (0)
#define ADA_MMA(kt) do { const LAS bf16* As = L0 + ((kt) & 1) * ABUF; const LAS bf16* Bs = As + 144 * 72; \
    if (PM == 0) { _Pragma("unroll") for (int ks = 0; ks < 2; ++ks) { bf16x8 a_[3], b_[3];     \
        _Pragma("unroll") for (int ni = 0; ni < 3; ++ni) { const int nr_ = 16 * (3 * ntg + ni) + fr; b_[ni] = *(const LAS bf16x8*)(Bs + nr_ * 72 + 8 * (((4 * ks + fq) ^ (nr_ >> 3)) & 7)); } \
        _Pragma("unroll") for (int mi = 0; mi < 2; ++mi) a_[mi] = *(const LAS bf16x8*)(As + (16 * (mt0 + mi) + fr) * 72 + 32 * ks + 8 * fq); \
        _Pragma("unroll") for (int mi = 0; mi < 2; ++mi) _Pragma("unroll") for (int ni = 0; ni < 3; ++ni) acc[3 * mi + ni] = __builtin_amdgcn_mfma_f32_16x16x32_bf16(a_[mi], b_[ni], acc[3 * mi + ni], 0, 0, 0); \
        if (mg == 0) { a_[2] = *(const LAS bf16x8*)(As + (16 * 2 + fr) * 72 + 32 * ks + 8 * fq); \
            _Pragma("unroll") for (int ni = 0; ni < 3; ++ni) acc[6 + ni] = __builtin_amdgcn_mfma_f32_16x16x32_bf16(a_[2], b_[ni], acc[6 + ni], 0, 0, 0); } } } } while (0)
#define ADA_STEP(s, kt) do { \
    ADA_LOADC(s, (kt) + 4); ADA_LOADW(s, (kt) + 4); __builtin_amdgcn_sched_barrier(0); \
    ADA_MMA(kt); \
    ADA_WRITE(((s) + 1) & 3, (kt) + 1); \
    __syncthreads(); } while (0)
    ADA_LOADC(0, 0); ADA_LOADW(0, 0); ADA_LOADC(1, 1); ADA_LOADW(1, 1); ADA_LOADC(2, 2); ADA_LOADW(2, 2); ADA_LOADC(3, 3); ADA_LOADW(3, 3);
    ADA_WRITE(0, 0); __syncthreads();
    for (int kt = 0; kt < 64; kt += 4) { ADA_STEP(0, kt); ADA_STEP(1, kt + 1); ADA_STEP(2, kt + 2); ADA_STEP(3, kt + 3); }
#undef ADA_WRITE
#undef ADA_MMA
#undef ADA_LOADW
#undef ADA_LOADC
#undef ADA_WB
#undef ADA_STEP
    float* MOD = (float*)(F.ws + WS_MOD); const float* bada = inptr(F, I_BADA) + (size_t)l * MODW; const int n0 = cb * 96;
#pragma unroll
    for (int mi = 0; mi < 3; ++mi) { if (PM == 0 && (mi < 2 || mg == 0)) {
#pragma unroll
        for (int ni = 0; ni < 3; ++ni) { const int mt = mt0 + mi, nt = 3 * ntg + ni; const int n = n0 + 16 * nt + fr; const float bb = bada[n];
#pragma unroll
            for (int rg = 0; rg < 4; ++rg) { const int row = 16 * mt + 4 * fq + rg; if (row < NSEQ) MOD[(size_t)(l * NSEQ + row) * MODW + n] = acc[3 * mi + ni][rg] + bb; } } } }
    __syncthreads();
}

__device__ __forceinline__ void adaln_task(const Frame& F, int l, int cb) { adaln_task_t<0>(F, l, cb); }
__device__ __forceinline__ void s5_mats(const Frame& F, int l, int g) {
    LAS float* PWr = (LAS float*)F.lds;
    LAS float* PWi = PWr + 9 * 64;
    LAS float* BBr = PWi + 9 * 64;
    LAS float* BBi = BBr + 1024;
    LAS float* CR = BBi + 1024;
    LAS float* CI = CR + 1024;
    LAS float* KT = CI + 1024;
    LAS float* DD = KT + 2048;
    const int tid = F.tid; const int lg = l * 64 + g;
    unsigned char* mb = F.ws + WS_S5M + (size_t)lg * S5M_STRIDE;
    const float* pDT = inptr(F, I_S5DT); const float* pLR = inptr(F, I_S5LR); const float* pLI = inptr(F, I_S5LI); const float* pBR = inptr(F, I_S5BR); const float* pBI = inptr(F, I_S5BI);
    const float* pCR = inptr(F, I_S5CR); const float* pCI = inptr(F, I_S5CI); const float* pD = inptr(F, I_S5D);
    if (tid < 64) {
        const int p = tid; const float dt = expf(pDT[lg]); const float lre = pLR[lg * 64 + p], lim = pLI[lg * 64 + p];
        f32x4 br4[4], bi4[4];
#pragma unroll
        for (int q = 0; q < 4; ++q) { br4[q] = *(const f32x4*)(pBR + (size_t)(lg * 64 + p) * 16 + 4 * q); bi4[q] = *(const f32x4*)(pBI + (size_t)(lg * 64 + p) * 16 + 4 * q); }
        const float mag = expf(lre * dt), ang = lim * dt; const float ar = mag * cosf(ang), ai = mag * sinf(ang);
        const float nr = ar - 1.0f, den = lre * lre + lim * lim; const float fr_ = (nr * lre + ai * lim) / den, fi_ = (ai * lre - nr * lim) / den;
        float pr = 1.f, pi = 0.f;
        for (int k = 0; k < 9; ++k) { PWr[k * 64 + p] = pr; PWi[k * 64 + p] = pi; const float t = pr * ar - pi * ai; pi = pr * ai + pi * ar; pr = t; }
#pragma unroll
        for (int j = 0; j < 16; ++j) { const float bre = br4[j >> 2][j & 3], bim = bi4[j >> 2][j & 3];
            BBr[p * 16 + j] = fr_ * bre - fi_ * bim; BBi[p * 16 + j] = fr_ * bim + fi_ * bre; }
        float* A8P = (float*)(mb + 98304); const float a8r = PWr[8 * 64 + p], a8i = PWi[8 * 64 + p]; float qr = a8r, qi = a8i;
        for (int k = 0; k < 4; ++k) { A8P[k * 128 + p] = qr; A8P[k * 128 + 64 + p] = qi; const float t = qr * a8r - qi * a8i; qi = qr * a8i + qi * a8r; qr = t; }
    }
    for (int i = tid; i < 1024; i += 512) { CR[i] = pCR[(size_t)lg * 1024 + i]; CI[i] = pCI[(size_t)lg * 1024 + i]; }
    if (tid < 16) DD[tid] = pD[lg * 16 + tid];
    __syncthreads();
    for (int e = tid; e < 2048; e += 512) { const int d = e >> 8, i = (e >> 4) & 15, j = e & 15; float s = 0.f;
        for (int p = 0; p < 64; ++p) { const float pr = PWr[d * 64 + p], pi = PWi[d * 64 + p], br = BBr[p * 16 + j], bi = BBi[p * 16 + j];
            const float zr = pr * br - pi * bi, zi = pr * bi + pi * br; s += CR[i * 64 + p] * zr - CI[i * 64 + p] * zi; }
        KT[e] = s; }
    __syncthreads();
    bf16* KM = (bf16*)mb; bf16* G8 = (bf16*)(mb + 32768); bf16* E8 = (bf16*)(mb + 65536);
    for (int q = tid; q < 2048; q += 512) { const int n = q >> 4, k0 = (q & 15) * 8;
        float v[8];
        { const int t = n >> 4, i = n & 15, s = k0 >> 4, j0 = k0 & 15;
#pragma unroll
          for (int e = 0; e < 8; ++e) { const int j = j0 + e; v[e] = (s <= t) ? (KT[((t - s) * 16 + i) * 16 + j] + ((s == t && i == j) ? DD[i] : 0.f)) : 0.f; }
          v4u o; o.x = pk2(v[0], v[1]); o.y = pk2(v[2], v[3]); o.z = pk2(v[4], v[5]); o.w = pk2(v[6], v[7]); *(v4u*)(KM + n * 128 + k0) = o; }
        { const int pb = n >> 5, ri = (n >> 4) & 1, p = 16 * pb + (n & 15), s = k0 >> 4, j0 = k0 & 15; const float pr = PWr[(7 - s) * 64 + p], pi = PWi[(7 - s) * 64 + p];
#pragma unroll
          for (int e = 0; e < 8; ++e) { const float br = BBr[p * 16 + j0 + e], bi = BBi[p * 16 + j0 + e]; v[e] = ri ? (pr * bi + pi * br) : (pr * br - pi * bi); }
          v4u o; o.x = pk2(v[0], v[1]); o.y = pk2(v[2], v[3]); o.z = pk2(v[4], v[5]); o.w = pk2(v[6], v[7]); *(v4u*)(G8 + n * 128 + k0) = o; }
        { const int t = n >> 4, i = n & 15, pb = k0 >> 5, ri = (k0 >> 4) & 1, p0 = 16 * pb + (k0 & 15);
#pragma unroll
          for (int e = 0; e < 8; ++e) { const int p = p0 + e; const float ar = PWr[(t + 1) * 64 + p], ai = PWi[(t + 1) * 64 + p], cr = CR[i * 64 + p], ci = CI[i * 64 + p];
              v[e] = ri ? -(cr * ai + ci * ar) : (cr * ar - ci * ai); }
          v4u o; o.x = pk2(v[0], v[1]); o.y = pk2(v[2], v[3]); o.z = pk2(v[4], v[5]); o.w = pk2(v[6], v[7]); *(v4u*)(E8 + n * 128 + k0) = o; }
    }
    __syncthreads();
}

template <bool XBF_P, bool XBF_S>
__device__ __forceinline__ void norm_phase(const Frame& F, const void* xp, const void* xs, int mode, int lm, const bf16* part, const float* gate, bf16* xdst) {
    const int gw = blockIdx.x * NWAVES + F.wave, NGW = F.G * NWAVES, lane = F.lane;
    const float* MOD = (const float*)(F.ws + WS_MOD); bf16* H = (bf16*)(F.ws + WS_HP);
    for (int row = gw; row < MROWS; row += NGW) {
        const bool smp = row >= NPROMPT; const size_t ro = (smp ? (size_t)(row - NPROMPT) : (size_t)row) * DM;
        f32x4 v[16]; float ss = 0.f;
#pragma unroll
        for (int j = 0; j < 8; ++j) { const int col = 8 * (lane + 64 * j); f32x4 a, b;
            if (!smp) {
                if (XBF_P) { const v4u t = *(const v4u*)((const bf16*)xp + ro + col); a = (f32x4){bflo(t.x), bfhi(t.x), bflo(t.y), bfhi(t.y)}; b = (f32x4){bflo(t.z), bfhi(t.z), bflo(t.w), bfhi(t.w)}; }
                else { const float* xr = (const float*)xp + ro + col; a = *(const f32x4*)xr; b = *(const f32x4*)(xr + 4); }
            } else {
                if (XBF_S) { const v4u t = *(const v4u*)((const bf16*)xs + ro + col); a = (f32x4){bflo(t.x), bfhi(t.x), bflo(t.y), bfhi(t.y)}; b = (f32x4){bflo(t.z), bfhi(t.z), bflo(t.w), bfhi(t.w)}; }
                else { const float* xr = (const float*)xs + ro + col; a = *(const f32x4*)xr; b = *(const f32x4*)(xr + 4); }
                if (part != nullptr) { const float* gr = gate + (size_t)seq_of_row(row) * MODW + col; const bf16* pp = part + ro + col;
                    const v4u q0 = *(const v4u*)pp, q1 = *(const v4u*)(pp + (size_t)1024 * DM), q2 = *(const v4u*)(pp + (size_t)2048 * DM), q3 = *(const v4u*)(pp + (size_t)3072 * DM);
                    const f32x4 pa = ((f32x4){bflo(q0.x), bfhi(q0.x), bflo(q0.y), bfhi(q0.y)} + (f32x4){bflo(q1.x), bfhi(q1.x), bflo(q1.y), bfhi(q1.y)}) + ((f32x4){bflo(q2.x), bfhi(q2.x), bflo(q2.y), bfhi(q2.y)} + (f32x4){bflo(q3.x), bfhi(q3.x), bflo(q3.y), bfhi(q3.y)});
                    const f32x4 pb = ((f32x4){bflo(q0.z), bfhi(q0.z), bflo(q0.w), bfhi(q0.w)} + (f32x4){bflo(q1.z), bfhi(q1.z), bflo(q1.w), bfhi(q1.w)}) + ((f32x4){bflo(q2.z), bfhi(q2.z), bflo(q2.w), bfhi(q2.w)} + (f32x4){bflo(q3.z), bfhi(q3.z), bflo(q3.w), bfhi(q3.w)});
                    a = a + *(const f32x4*)gr * pa; b = b + *(const f32x4*)(gr + 4) * pb;
                    if (xdst) { v4u w; w.x = pk2(a.x, a.y); w.y = pk2(a.z, a.w); w.z = pk2(b.x, b.y); w.w = pk2(b.z, b.w); *(v4u*)(xdst + ro + col) = w; } }
            }
            v[2 * j] = a; v[2 * j + 1] = b; ss += ((a.x * a.x + a.y * a.y) + (a.z * a.z + a.w * a.w)) + ((b.x * b.x + b.y * b.y) + (b.z * b.z + b.w * b.w)); }
        ss = wave_sum(ss); const float rstd = 1.0f / sqrtf(ss * (1.0f / DM) + RMS_EPS);
        if (mode == 0) {
            const float* md = MOD + (size_t)(lm * NSEQ + seq_of_row(row)) * MODW; const float* gn = inptr(F, I_GN) + (size_t)lm * DM;
#pragma unroll
            for (int j = 0; j < 8; ++j) { const int col = 8 * (lane + 64 * j);
                const f32x4 o0 = v[2 * j] * rstd * *(const f32x4*)(gn + col) * (*(const f32x4*)(md + DM + col) + 1.0f) + *(const f32x4*)(md + col);
                const f32x4 o1 = v[2 * j + 1] * rstd * *(const f32x4*)(gn + col + 4) * (*(const f32x4*)(md + DM + col + 4) + 1.0f) + *(const f32x4*)(md + col + 4);
                v4u w; w.x = pk2(o0.x, o0.y); w.y = pk2(o0.z, o0.w); w.z = pk2(o1.x, o1.y); w.w = pk2(o1.z, o1.w); *(v4u*)(H + (size_t)row * LDK + col) = w; }
        } else {
            const float* gn = inptr(F, I_GFIN); float* orow = F.out + O_Y + (size_t)row * DM;
#pragma unroll
            for (int j = 0; j < 8; ++j) { const int col = 8 * (lane + 64 * j);
                *(f32x4*)(orow + col) = v[2 * j] * rstd * *(const f32x4*)(gn + col); *(f32x4*)(orow + col + 4) = v[2 * j + 1] * rstd * *(const f32x4*)(gn + col + 4); }
        }
    }
}

constexpr int OFF_CIN = 0, OFF_PG = 1024;
struct EpiProj {
    static constexpr bool PERM = true, AFTER_DRAIN = false;
    bf16* O;
    __device__ __forceinline__ void operator()(const f32x4 (&acc)[2][2][4][2], const pg8::Unit& u, int wr, int wc, int fr, int fq) const {
        const int row0 = u.pm * 256 + wr * 64 + fr;
        if (u.pn < 16) { const int ch = 64 * u.pn + 32 * (wc & 1) + 8 * fq; const bool gatep = wc >= 2;
#pragma unroll
            for (int ai = 0; ai < 2; ++ai)
#pragma unroll
                for (int m = 0; m < 4; ++m) { bf16* rowp = O + (size_t)(row0 + ai * 128 + m * 16) * INC + (gatep ? OFF_PG : OFF_CIN) + ch;
                    const f32x4 p0 = acc[ai][0][m][0], p1 = acc[ai][0][m][1], q0 = acc[ai][1][m][0], q1 = acc[ai][1][m][1]; f32x4 r0, r1;
                    if (gatep) { r0 = (f32x4){p0[0] * silu(q0[0]), p0[1] * silu(q0[1]), p0[2] * silu(q0[2]), p0[3] * silu(q0[3])}; r1 = (f32x4){p1[0] * silu(q1[0]), p1[1] * silu(q1[1]), p1[2] * silu(q1[2]), p1[3] * silu(q1[3])}; }
                    else { r0 = p0 * q0; r1 = p1 * q1; }
                    v4u w; w.x = pg8::cvt_pk_bf16(r0[0], r0[1]); w.y = pg8::cvt_pk_bf16(r0[2], r0[3]); w.z = pg8::cvt_pk_bf16(r1[0], r1[1]); w.w = pg8::cvt_pk_bf16(r1[2], r1[3]);
                    *(v4u*)rowp = w; }
            return; }
        const int col0 = u.pn * 256 + wc * 32 + 8 * fq;
#pragma unroll
        for (int ai = 0; ai < 2; ++ai)
#pragma unroll
            for (int m = 0; m < 4; ++m) { bf16* rowp = O + (size_t)(row0 + ai * 128 + m * 16) * INC + col0;
#pragma unroll
                for (int bj = 0; bj < 2; ++bj) { const f32x4 v0 = acc[ai][bj][m][0], v1 = acc[ai][bj][m][1];
                    v4u w; w.x = pg8::cvt_pk_bf16(v0[0], v0[1]); w.y = pg8::cvt_pk_bf16(v0[2], v0[3]); w.z = pg8::cvt_pk_bf16(v1[0], v1[1]); w.w = pg8::cvt_pk_bf16(v1[2], v1[3]);
                    *(v4u*)(rowp + bj * 128) = w; } }
    }
};
template <bool XBF> struct EpiResGate {
    static constexpr bool PERM = true, AFTER_DRAIN = false;
    const void* xp; const void* xs; bf16* out; const float* gate;
    bf16* part;
    __device__ __forceinline__ void operator()(const f32x4 (&acc)[2][2][4][2], const pg8::Unit& u, int wr, int wc, int fr, int fq) const {
        const int row0 = u.pm * 256 + wr * 64 + fr, col0 = u.pn * 256 + wc * 32 + 8 * fq;
        if (u.nkt != 64) { bf16* pb = part + (size_t)(u.kt0 >> 4) * 1024 * DM;
#pragma unroll
            for (int ai = 0; ai < 2; ++ai)
#pragma unroll
                for (int m = 0; m < 4; ++m) { bf16* orow = pb + (size_t)(row0 + ai * 128 + m * 16 - NPROMPT) * DM + col0;
#pragma unroll
                    for (int bj = 0; bj < 2; ++bj) { const f32x4 a0 = acc[ai][bj][m][0], a1 = acc[ai][bj][m][1]; v4u w; w.x = pk2(a0[0], a0[1]); w.y = pk2(a0[2], a0[3]); w.z = pk2(a1[0], a1[1]); w.w = pk2(a1[2], a1[3]);
                        *(v4u*)(orow + bj * 128) = w; } }
            return; }
        const bool uni = u.pm < 32;
        f32x4 g0[2], g1[2];
        { const float* gr = gate + (size_t)(uni ? (u.pm >> 3) : 0) * MODW + col0;
#pragma unroll
          for (int bj = 0; bj < 2; ++bj) { g0[bj] = *(const f32x4*)(gr + bj * 128); g1[bj] = *(const f32x4*)(gr + bj * 128 + 4); } }
#pragma unroll
        for (int ai = 0; ai < 2; ++ai)
#pragma unroll
            for (int m = 0; m < 4; ++m) { const int row = row0 + ai * 128 + m * 16; const bool smp = row >= NPROMPT; const size_t ro = (smp ? (size_t)(row - NPROMPT) : (size_t)row) * DM + col0;
                if (!uni) { const float* gr = gate + (size_t)seq_of_row(row) * MODW + col0;
#pragma unroll
                    for (int bj = 0; bj < 2; ++bj) { g0[bj] = *(const f32x4*)(gr + bj * 128); g1[bj] = *(const f32x4*)(gr + bj * 128 + 4); } }
#pragma unroll
                for (int bj = 0; bj < 2; ++bj) { f32x4 x0, x1;
                    if (XBF) { const v4u t = *(const v4u*)((const bf16*)(smp ? xs : xp) + ro + bj * 128); x0 = (f32x4){bflo(t.x), bfhi(t.x), bflo(t.y), bfhi(t.y)}; x1 = (f32x4){bflo(t.z), bfhi(t.z), bflo(t.w), bfhi(t.w)}; }
                    else { const float* xr = (const float*)(smp ? xs : xp) + ro + bj * 128; x0 = *(const f32x4*)xr; x1 = *(const f32x4*)(xr + 4); }
                    const f32x4 o0 = x0 + g0[bj] * acc[ai][bj][m][0], o1 = x1 + g1[bj] * acc[ai][bj][m][1];
                    v4u w; w.x = pk2(o0[0], o0[1]); w.y = pk2(o0[2], o0[3]); w.z = pk2(o1[0], o1[1]); w.w = pk2(o1[2], o1[3]);
                    *(v4u*)(out + (size_t)row * DM + col0 + bj * 128) = w; }
                asm volatile("" ::: "memory"); }
    }
};
struct Gemm2Order {
    pg8::StaticOrder so; int c; bool split;
    __device__ __forceinline__ void init(int G, int c_) { split = true; c = c_; so.init(NPROMPT, DM, G, c_, DM); }
    __device__ __forceinline__ bool next(int i, pg8::Unit& u) const {
        if (!split || i < 2) return so.next(i, u);
        if (i == 2) { const int x = c & 7, j = c >> 3; u.pm = 32 + (j & 3); u.pn = 8 * (x >> 2) + (j >> 2); u.kt0 = 16 * (x & 3); u.nkt = 16; return true; }
        return false;
    }
    __device__ __forceinline__ void a_ready(const pg8::Unit&) const {}
    __device__ __forceinline__ void done(const pg8::Unit&) const {}
};
struct EpiGlu {
    static constexpr bool PERM = true, AFTER_DRAIN = false;
    const bf16* YG; const bf16* PROJ; const float* bglu; bf16* MIX;
    __device__ __forceinline__ void operator()(const f32x4 (&acc)[2][2][4][2], const pg8::Unit& u, int wr, int wc, int fr, int fq) const {
        const int row0 = u.pm * 256 + wr * 64 + fr, col0 = u.pn * 256 + wc * 32 + 8 * fq;
#pragma unroll
        for (int bj = 0; bj < 2; ++bj) { const int col = col0 + bj * 128; const f32x4 b0 = *(const f32x4*)(bglu + col), b1 = *(const f32x4*)(bglu + col + 4);
#pragma unroll
            for (int ai = 0; ai < 2; ++ai)
#pragma unroll
                for (int m = 0; m < 4; ++m) { const int row = row0 + ai * 128 + m * 16;
                    const v4u yv = *(const v4u*)(YG + (size_t)row * 1024 + col), cv = *(const v4u*)(PROJ + (size_t)row * INC + OFF_CG + col);
                    float y[8], c[8]; UNPK8(yv, y); UNPK8(cv, c);
                    const f32x4 z0 = acc[ai][bj][m][0] + b0, z1 = acc[ai][bj][m][1] + b1; float o[8];
#pragma unroll
                    for (int e = 0; e < 4; ++e) { o[e] = y[e] * sigm(z0[e]) * silu(c[e]); o[4 + e] = y[4 + e] * sigm(z1[e]) * silu(c[4 + e]); }
                    v4u w; w.x = pg8::cvt_pk_bf16(o[0], o[1]); w.y = pg8::cvt_pk_bf16(o[2], o[3]); w.z = pg8::cvt_pk_bf16(o[4], o[5]); w.w = pg8::cvt_pk_bf16(o[6], o[7]);
                    *(v4u*)(MIX + (size_t)row * DM + 3072 + col) = w; } }
    }
};

__device__ __forceinline__ void s5_phase(const Frame& F, int l) {
    const int wg = blockIdx.x; if (wg >= 256) return;
    const int g = wg & 63, pbq = wg >> 6; const int lane = F.lane, w = F.wave, fr = lane & 15, fq = lane >> 4;
    const unsigned char* mb = F.ws + WS_S5M + (size_t)(l * 64 + g) * S5M_STRIDE;
    const bf16* KM = (const bf16*)mb; const bf16* G8 = (const bf16*)(mb + 32768); const bf16* E8 = (const bf16*)(mb + 65536); const float* A8P = (const float*)(mb + 98304);
    const bf16* PROJ = (const bf16*)(F.ws + WS_PROJ); bf16* YG = (bf16*)(F.ws + WS_YG);
    bf16x8 BK[4], BE[4], BG0[4], BG1[4];
#pragma unroll
    for (int kk = 0; kk < 4; ++kk) { BK[kk] = *(const bf16x8*)(KM + (16 * w + fr) * 128 + 32 * kk + 8 * fq); BE[kk] = *(const bf16x8*)(E8 + (16 * w + fr) * 128 + 32 * kk + 8 * fq); }
    const int wg2 = (w & 3);
#pragma unroll
    for (int kk = 0; kk < 4; ++kk) { BG0[kk] = *(const bf16x8*)(G8 + (16 * (2 * wg2) + fr) * 128 + 32 * kk + 8 * fq); BG1[kk] = *(const bf16x8*)(G8 + (16 * (2 * wg2 + 1) + fr) * 128 + 32 * kk + 8 * fq); }
    const int p = 16 * wg2 + fr;
    const float a1r = A8P[p], a1i = A8P[64 + p], a2r = A8P[128 + p], a2i = A8P[192 + p], a3r = A8P[256 + p], a3i = A8P[320 + p], a4r = A8P[384 + p], a4i = A8P[448 + p];
    float cr_ = 0.f, ci_ = 0.f;
    float hS0r[4], hS0i[4], hS1r[4], hS1i[4];
    { const float* SRE = inptr(F, I_SRE); const float* SIM = inptr(F, I_SIM);
#pragma unroll
      for (int r = 0; r < 4; ++r) { const size_t s0 = (size_t)((l * 128 + 16 * pbq + 4 * fq + r) * 64 + g) * 64 + p, s1 = (size_t)((l * 128 + 16 * (pbq + 4) + 4 * fq + r) * 64 + g) * 64 + p;
          hS0r[r] = SRE[s0]; hS0i[r] = SIM[s0]; hS1r[r] = SRE[s1]; hS1i[r] = SIM[s1]; } }
    LAS bf16* HT = (LAS bf16*)F.lds;
    LAS bf16* YS = HT + 2 * 16 * 136;
    bf16x8 U0[4], U1[4], U2[4];
#define S5_ROW0(it_) ((it_) >= 16 ? NPROMPT + 128 * (pbq + 4 * ((it_) - 16)) : pbq * 2048 + 128 * (it_))
#pragma unroll
    for (int kk = 0; kk < 4; ++kk) { U0[kk] = *(const bf16x8*)(PROJ + (size_t)(S5_ROW0(0) + 8 * fr + 2 * kk + (fq >> 1)) * INC + OFF_CU + 16 * g + 8 * (fq & 1));
        U1[kk] = *(const bf16x8*)(PROJ + (size_t)(S5_ROW0(1) + 8 * fr + 2 * kk + (fq >> 1)) * INC + OFF_CU + 16 * g + 8 * (fq & 1));
        U2[kk] = *(const bf16x8*)(PROJ + (size_t)(S5_ROW0(2) + 8 * fr + 2 * kk + (fq >> 1)) * INC + OFF_CU + 16 * g + 8 * (fq & 1)); }
#define S5_BODY(U_, itx, SL) do { const int it = (itx); const bool smp = it >= 16; const int row0 = S5_ROW0(it); \
        LAS bf16* hb = HT + (it & 1) * 16 * 136; \
        f32x4 Y = (f32x4){0.f, 0.f, 0.f, 0.f}, S0 = (f32x4){0.f, 0.f, 0.f, 0.f}, S1 = (f32x4){0.f, 0.f, 0.f, 0.f}; \
        _Pragma("unroll") \
        for (int kk = 0; kk < 4; ++kk) { Y = __builtin_amdgcn_mfma_f32_16x16x32_bf16(U_[kk], BK[kk], Y, 0, 0, 0); S0 = __builtin_amdgcn_mfma_f32_16x16x32_bf16(U_[kk], BG0[kk], S0, 0, 0, 0); S1 = __builtin_amdgcn_mfma_f32_16x16x32_bf16(U_[kk], BG1[kk], S1, 0, 0, 0); } \
        asm volatile("" : "+v"(Y), "+v"(S0), "+v"(S1)); \
        { const int itn = it + 3 < 18 ? it + 3 : it; const int rn = S5_ROW0(itn); \
        _Pragma("unroll") \
            for (int kk = 0; kk < 4; ++kk) U_[kk] = *(const bf16x8*)(PROJ + (size_t)(rn + 8 * fr + 2 * kk + (fq >> 1)) * INC + OFF_CU + 16 * g + 8 * (fq & 1)); } \
        if (w < 4) { \
            float hr[4], hi[4]; \
            if (!smp) { \
                float Lr[4], Li[4]; Lr[0] = S0[0]; Li[0] = S1[0]; \
        _Pragma("unroll") \
                for (int r = 1; r < 4; ++r) { Lr[r] = a1r * Lr[r - 1] - a1i * Li[r - 1] + S0[r]; Li[r] = a1r * Li[r - 1] + a1i * Lr[r - 1] + S1[r]; } \
                float tr = cr_, ti = ci_, br = cr_, bi = ci_; \
        _Pragma("unroll") \
                for (int q = 0; q < 4; ++q) { const float er = __shfl(Lr[3], fr + 16 * q), ei = __shfl(Li[3], fr + 16 * q); \
                    const float ntr = a4r * tr - a4i * ti + er, nti = a4r * ti + a4i * tr + ei; tr = ntr; ti = nti; if (fq == q + 1) { br = tr; bi = ti; } } \
                cr_ = tr; ci_ = ti; \
                hr[0] = br; hi[0] = bi; \
                hr[1] = a1r * br - a1i * bi + Lr[0]; hi[1] = a1r * bi + a1i * br + Li[0]; \
                hr[2] = a2r * br - a2i * bi + Lr[1]; hi[2] = a2r * bi + a2i * br + Li[1]; \
                hr[3] = a3r * br - a3i * bi + Lr[2]; hi[3] = a3r * bi + a3i * br + Li[2]; \
            } else { \
        _Pragma("unroll") \
                for (int r = 0; r < 4; ++r) { const int b = 16 * (pbq + 4 * (it - 16)) + 4 * fq + r; const size_t si = (size_t)((l * 128 + b) * 64 + g) * 64 + p; \
                    hr[r] = (SL) ? hS1r[r] : hS0r[r]; hi[r] = (SL) ? hS1i[r] : hS0i[r]; \
                    F.out[O_SRE + si] = a1r * hr[r] - a1i * hi[r] + S0[r]; F.out[O_SIM + si] = a1r * hi[r] + a1i * hr[r] + S1[r]; } \
            } \
        _Pragma("unroll") \
            for (int r = 0; r < 4; ++r) { hb[(4 * fq + r) * 136 + 32 * w + fr] = (bf16)f2bf(hr[r]); hb[(4 * fq + r) * 136 + 32 * w + 16 + fr] = (bf16)f2bf(hi[r]); } \
        } \
        __syncthreads(); \
        if (it > 0 && F.tid < 256) { const int rp_ = S5_ROW0(it - 1) + (F.tid >> 1);     \
            *(v4u*)(YG + (size_t)rp_ * 1024 + 16 * g + 8 * (F.tid & 1)) = *(const LAS v4u*)(YS + ((it - 1) & 1) * 2048 + (F.tid >> 1) * 16 + 8 * (F.tid & 1)); } \
        _Pragma("unroll") \
        for (int kk = 0; kk < 4; ++kk) { const bf16x8 HA = *(const LAS bf16x8*)(hb + fr * 136 + 32 * kk + 8 * fq); Y = __builtin_amdgcn_mfma_f32_16x16x32_bf16(HA, BE[kk], Y, 0, 0, 0); } \
        _Pragma("unroll") \
        for (int r = 0; r < 4; ++r) YS[(it & 1) * 2048 + (8 * (4 * fq + r) + w) * 16 + fr] = (bf16)f2bf(gelu_tanh(Y[r])); \
    } while (0)
    for (int it3 = 0; it3 < 18; it3 += 3) { S5_BODY(U0, it3, 0); S5_BODY(U1, it3 + 1, 0); S5_BODY(U2, it3 + 2, 1); }
#undef S5_BODY
    if (w < 4 && fq == 0) { const size_t si = (size_t)((l * 4 + pbq) * 64 + g) * 64 + p; F.out[O_PRE + si] = cr_; F.out[O_PIM + si] = ci_; }
    __syncthreads();
    if (F.tid < 256) { const int rp_ = S5_ROW0(17) + (F.tid >> 1); *(v4u*)(YG + (size_t)rp_ * 1024 + 16 * g + 8 * (F.tid & 1)) = *(const LAS v4u*)(YS + 2048 + (F.tid >> 1) * 16 + 8 * (F.tid & 1)); }
    __syncthreads();
}

constexpr int B1S = 132;
__device__ __forceinline__ void b1_phase(const Frame& F, int l) {
    LAS float* MAIN = (LAS float*)F.lds;
    LAS float* XB = MAIN + 64 * B1S;
    LAS float* BT = XB + 64 * B1S;
    LAS float* HALO = BT + 64 * B1S;
    LAS float* SEGP = HALO + 8 * 3 * 128;
    LAS float* SEGH = SEGP + 512;
    LAS bf16* XA = (LAS bf16*)(SEGH + 512);
    static_assert(3 * 64 * B1S * 4 + 8 * 3 * 128 * 4 + 2 * 512 * 4 + 64 * 136 * 2 <= LDSCTL_OFF, "B1 LDS");
    const int tid = F.tid, lane = F.lane, w = F.wave, fr = lane & 15, fq = lane >> 4;
    const bf16* PROJ = (const bf16*)(F.ws + WS_PROJ); unsigned* HP = (unsigned*)(F.ws + WS_HLOC);
    float* SUMA = (float*)(F.ws + WS_SUMA); float* SUMH = (float*)(F.ws + WS_SUMH);
    const float* SCB = inptr(F, I_SCB);
    v4u nm0, nm1, nh; f32x4 ns0, ns1;
    nm0 = nm1 = nh = (v4u){0u, 0u, 0u, 0u}; ns0 = ns1 = (f32x4){0.f, 0.f, 0.f, 0.f};
#define B1_ISSUE(tt) do { const int c_ = (tt) >> 4, hd_ = (tt) & 15, row0_ = c_ * 64, ch0_ = hd_ * 128; const int cs_ = c_ >= 128 ? c_ - 128 : 0;     \
        nm0 = *(const v4u*)(PROJ + (size_t)(row0_ + (tid >> 4)) * INC + OFF_BX + ch0_ + 8 * (tid & 15)); \
        nm1 = *(const v4u*)(PROJ + (size_t)(row0_ + 32 + (tid >> 4)) * INC + OFF_BX + ch0_ + 8 * (tid & 15)); \
        { const int hr_ = row0_ >= 3 ? row0_ - 3 + ((tid >> 4) < 3 ? (tid >> 4) : 0) : 0; nh = *(const v4u*)(PROJ + (size_t)hr_ * INC + OFF_BX + ch0_ + 8 * (tid & 15)); } \
        { const int sq = tid / 96, rem = tid % 96, j = rem >> 5, c4 = rem & 31; ns0 = *(const f32x4*)(SCB + (size_t)((l * 128 + 8 * cs_ + sq) * 3 + j) * 2048 + ch0_ + 4 * c4); } \
        { const int idx = (tid < 256 ? tid : 255) + 512; const int sq = idx / 96, rem = idx % 96, j = rem >> 5, c4 = rem & 31; ns1 = *(const f32x4*)(SCB + (size_t)((l * 128 + 8 * cs_ + sq) * 3 + j) * 2048 + ch0_ + 4 * c4); } } while (0)
    if ((int)blockIdx.x < 2304) B1_ISSUE((int)blockIdx.x);
    float w0 = 0.f, w1 = 0.f, w2 = 0.f, w3 = 0.f, bias = 0.f; f32x4 brg4 = (f32x4){0.f, 0.f, 0.f, 0.f}, big4 = brg4, sp84 = brg4; bf16x8 BR[4], BI[4]; int hdc = -1;
#define B1_LOADW(hd_) do { const int chx = (hd_) * 128 + (tid & 127); const float* wc_ = inptr(F, I_WCB) + (size_t)l * 4 * 2048 + chx; w0 = wc_[0]; w1 = wc_[2048]; w2 = wc_[4096]; w3 = wc_[6144]; bias = inptr(F, I_BCB)[l * 2048 + chx]; \
        const bf16* WR = (const bf16*)(F.ws + WS_WRGT) + (size_t)((l * 16 + (hd_)) * 128 + 16 * w + fr) * 128 + 8 * fq; const bf16* WI = (const bf16*)(F.ws + WS_WIGT) + (size_t)((l * 16 + (hd_)) * 128 + 16 * w + fr) * 128 + 8 * fq; \
        _Pragma("unroll") for (int kk = 0; kk < 4; ++kk) { BR[kk] = *(const bf16x8*)(WR + 32 * kk); BI[kk] = *(const bf16x8*)(WI + 32 * kk); } \
        brg4 = *(const f32x4*)(inptr(F, I_BRG) + (l * 16 + (hd_)) * 128 + 16 * w + 4 * fq); big4 = *(const f32x4*)(inptr(F, I_BIG) + (l * 16 + (hd_)) * 128 + 16 * w + 4 * fq); \
        { const f32x4 lm_ = *(const f32x4*)(inptr(F, I_LAM) + l * 2048 + (hd_) * 128 + 16 * w + 4 * fq); \
          _Pragma("unroll") for (int e_ = 0; e_ < 4; ++e_) sp84[e_] = -8.0f * 1.4426950408889634f * log1pf(__expf(-lm_[e_])); } } while (0)
    for (int ti = blockIdx.x; ti < 2304; ti += F.G) {
        const int c = ti >> 4, hd = ti & 15; const bool smp = c >= 128; const int row0 = c * 64, ch0 = hd * 128;
        if (hd != hdc) { B1_LOADW(hd); hdc = hd; }
        { float f[8]; const int r = tid >> 4, c8 = tid & 15;
          UNPK8(nm0, f); *(LAS f32x4*)(MAIN + r * B1S + 8 * c8) = (f32x4){f[0], f[1], f[2], f[3]}; *(LAS f32x4*)(MAIN + r * B1S + 8 * c8 + 4) = (f32x4){f[4], f[5], f[6], f[7]};
          UNPK8(nm1, f); *(LAS f32x4*)(MAIN + (r + 32) * B1S + 8 * c8) = (f32x4){f[0], f[1], f[2], f[3]}; *(LAS f32x4*)(MAIN + (r + 32) * B1S + 8 * c8 + 4) = (f32x4){f[4], f[5], f[6], f[7]};
          if (!smp) { if (tid < 48) { if ((c & 31) == 0) nh = (v4u){0u, 0u, 0u, 0u}; UNPK8(nh, f); *(LAS f32x4*)(HALO + r * 128 + 8 * c8) = (f32x4){f[0], f[1], f[2], f[3]}; *(LAS f32x4*)(HALO + r * 128 + 8 * c8 + 4) = (f32x4){f[4], f[5], f[6], f[7]}; } }
          else { { const int sq = tid / 96, rem = tid % 96, j = rem >> 5, c4 = rem & 31; *(LAS f32x4*)(HALO + (sq * 3 + j) * 128 + 4 * c4) = ns0; }
                 if (tid < 256) { const int idx = tid + 512; const int sq = idx / 96, rem = idx % 96, j = rem >> 5, c4 = rem & 31; *(LAS f32x4*)(HALO + (sq * 3 + j) * 128 + 4 * c4) = ns1; } } }
        __syncthreads();
        B1_ISSUE(ti + F.G < 2304 ? ti + F.G : ti);
        const int ch = tid & 127, sg = tid >> 7;
        {
            float x1, x2, x3;
            { const int r = 16 * sg; if (smp || r == 0) { const int hb_ = smp ? (r >> 3) * 3 : 0; x3 = HALO[hb_ * 128 + ch]; x2 = HALO[(hb_ + 1) * 128 + ch]; x1 = HALO[(hb_ + 2) * 128 + ch]; }
              else { x3 = MAIN[(r - 3) * B1S + ch]; x2 = MAIN[(r - 2) * B1S + ch]; x1 = MAIN[(r - 1) * B1S + ch]; } }
#pragma unroll
            for (int rr = 0; rr < 16; ++rr) { const int r = 16 * sg + rr;
                if (smp && rr == 8) { const int hb_ = (r >> 3) * 3; x3 = HALO[hb_ * 128 + ch]; x2 = HALO[(hb_ + 1) * 128 + ch]; x1 = HALO[(hb_ + 2) * 128 + ch]; }
                const float x0 = MAIN[r * B1S + ch];
                const float xb = bias + w3 * x0 + w2 * x1 + w1 * x2 + w0 * x3;
                XB[r * B1S + ch] = xb; XA[r * 136 + ch] = (bf16)f2bf(xb); x3 = x2; x2 = x1; x1 = x0; }
            if (!smp) { if ((c & 31) == 31 && sg == 3) { const int seq = c >> 5;
#pragma unroll
                    for (int j = 0; j < 3; ++j) F.out[O_PCB + (size_t)((l * 4 + seq) * 3 + j) * 2048 + ch0 + ch] = MAIN[(61 + j) * B1S + ch]; } }
            else {
#pragma unroll
                for (int s2 = 0; s2 < 2; ++s2) { const int sq = 2 * sg + s2, b = 8 * (c - 128) + sq;
#pragma unroll
                    for (int j = 0; j < 3; ++j) F.out[O_SCB + (size_t)((l * 128 + b) * 3 + j) * 2048 + ch0 + ch] = MAIN[(8 * sq + 5 + j) * B1S + ch]; } }
        }
        __syncthreads();
        {
            f32x4 zr[4], zi[4];
#pragma unroll
            for (int mt = 0; mt < 4; ++mt) { zr[mt] = (f32x4){0.f, 0.f, 0.f, 0.f}; zi[mt] = (f32x4){0.f, 0.f, 0.f, 0.f}; }
#pragma unroll
            for (int mt = 0; mt < 4; ++mt)
#pragma unroll
                for (int kk = 0; kk < 4; ++kk) { const bf16x8 ax = *(const LAS bf16x8*)(XA + (16 * mt + fr) * 136 + 32 * kk + 8 * fq);
                    zr[mt] = __builtin_amdgcn_mfma_f32_16x16x32_bf16(BR[kk], ax, zr[mt], 0, 0, 0); zi[mt] = __builtin_amdgcn_mfma_f32_16x16x32_bf16(BI[kk], ax, zi[mt], 0, 0, 0); }
            float A_[4][4], H_[4][4];
#pragma unroll
            for (int mt = 0; mt < 4; ++mt) { const f32x4 xv = *(const LAS f32x4*)(XB + (16 * mt + fr) * B1S + 16 * w + 4 * fq);
#pragma unroll
                for (int rg = 0; rg < 4; ++rg) { const float rr_ = sigm(zr[mt][rg] + brg4[rg]), ig = sigm(zi[mt][rg] + big4[rg]);
                    const float av = __builtin_amdgcn_exp2f(sp84[rg] * rr_); const float beta = __builtin_amdgcn_sqrtf(fmaxf(1.0f - av * av, 0.f));
                    A_[mt][rg] = av; H_[mt][rg] = beta * ig * xv[rg]; } }
#define B1_SHR(x, d, ident) __builtin_bit_cast(float, __builtin_amdgcn_update_dpp(__builtin_bit_cast(int, (float)(ident)), __builtin_bit_cast(int, (float)(x)), 0x110 + (d), 0xf, 0xf, false))
#define B1_SCAN_STEP(d, seg) do { _Pragma("unroll") for (int mt = 0; mt < 4; ++mt) _Pragma("unroll") for (int rg = 0; rg < 4; ++rg) { \
                float as_ = B1_SHR(A_[mt][rg], d, 1.0f), hs_ = B1_SHR(H_[mt][rg], d, 0.0f); if ((seg) && (fr & 7) < (d)) { as_ = 1.0f; hs_ = 0.0f; } \
                H_[mt][rg] = A_[mt][rg] * hs_ + H_[mt][rg]; A_[mt][rg] *= as_; } } while (0)
            if (!smp) {
#define B1_DPP_STEP(d) do { _Pragma("unroll") for (int mt = 0; mt < 4; ++mt) _Pragma("unroll") for (int rg = 0; rg < 4; ++rg) \
                    asm volatile("s_nop 1\n\tv_fmac_f32_dpp %0, %0, %1 row_shr:" #d " row_mask:0xf bank_mask:0xf\n\tv_mul_f32_dpp %1, %1, %1 row_shr:" #d " row_mask:0xf bank_mask:0xf" : "+v"(H_[mt][rg]), "+v"(A_[mt][rg])); } while (0)
                B1_DPP_STEP(1); B1_DPP_STEP(2); B1_DPP_STEP(4); B1_DPP_STEP(8);
#undef B1_DPP_STEP
                float cP[4], cH[4];
#pragma unroll
                for (int mt = 0; mt < 4; ++mt)
#pragma unroll
                    for (int rg = 0; rg < 4; ++rg) { if (mt > 0) { H_[mt][rg] = H_[mt][rg] + A_[mt][rg] * cH[rg]; A_[mt][rg] *= cP[rg]; }
                        cH[rg] = __shfl(H_[mt][rg], (lane & 48) | 15); cP[rg] = __shfl(A_[mt][rg], (lane & 48) | 15); }
                if (fr == 15) { *(f32x4*)(SUMA + (size_t)c * 2048 + ch0 + 16 * w + 4 * fq) = (f32x4){A_[3][0], A_[3][1], A_[3][2], A_[3][3]};
                                *(f32x4*)(SUMH + (size_t)c * 2048 + ch0 + 16 * w + 4 * fq) = (f32x4){H_[3][0], H_[3][1], H_[3][2], H_[3][3]}; }
            } else { B1_SCAN_STEP(1, true); B1_SCAN_STEP(2, true); B1_SCAN_STEP(4, true); }
#undef B1_SCAN_STEP
#undef B1_SHR
#pragma unroll
            for (int mt = 0; mt < 4; ++mt) { v4u o; o.x = pk2(H_[mt][0], A_[mt][0]); o.y = pk2(H_[mt][1], A_[mt][1]); o.z = pk2(H_[mt][2], A_[mt][2]); o.w = pk2(H_[mt][3], A_[mt][3]);
                *(v4u*)(HP + (size_t)(row0 + 16 * mt + fr) * 2048 + ch0 + 16 * w + 4 * fq) = o; }
        }
    }
    __syncthreads();
}

__device__ __forceinline__ void mixa_item(const Frame& F, int l, int item) {
    const bf16* PROJ = (const bf16*)(F.ws + WS_PROJ); bf16* MIX = (bf16*)(F.ws + WS_MIX);
    {
        const int c8 = item >> 7, strip = item & 127, r0 = 8 * c8, ch = 8 * strip; const bool smp = r0 >= NPROMPT; const int t0 = smp ? 0 : (r0 & 2047);
        float w0[8], w1[8], w2[8], bs[8], p2[8], p1[8];
        { const float* wa = inptr(F, I_WCA) + (size_t)l * 3 * 1024 + ch; const float* ba = inptr(F, I_BCA) + l * 1024 + ch;
#pragma unroll
          for (int h = 0; h < 2; ++h) { const f32x4 a = *(const f32x4*)(wa + 4 * h), b = *(const f32x4*)(wa + 1024 + 4 * h), cc = *(const f32x4*)(wa + 2048 + 4 * h), d = *(const f32x4*)(ba + 4 * h);
#pragma unroll
              for (int e = 0; e < 4; ++e) { w0[4 * h + e] = a[e]; w1[4 * h + e] = b[e]; w2[4 * h + e] = cc[e]; bs[4 * h + e] = d[e]; } } }
        if (t0 >= 2) {
            const v4u c2 = *(const v4u*)(PROJ + (size_t)(r0 - 2) * INC + OFF_CIN + ch), c1 = *(const v4u*)(PROJ + (size_t)(r0 - 1) * INC + OFF_CIN + ch);
            UNPK8(c2, p2); UNPK8(c1, p1);
        } else if (!smp) {
#pragma unroll
            for (int e = 0; e < 8; ++e) { p2[e] = 0.f; p1[e] = 0.f; }
        } else { const int b = (r0 - NPROMPT) >> 3; const float* st = inptr(F, I_SCA) + (size_t)((l * 128 + b) * 2) * 1024 + ch;
#pragma unroll
            for (int h = 0; h < 2; ++h) { const f32x4 a = *(const f32x4*)(st + 4 * h), bb = *(const f32x4*)(st + 1024 + 4 * h);
#pragma unroll
                for (int e = 0; e < 4; ++e) { p2[4 * h + e] = a[e]; p1[4 * h + e] = bb[e]; } } }
        v4u vc[8], vp[8];
#pragma unroll
        for (int r = 0; r < 8; ++r) { const bf16* pr = PROJ + (size_t)(r0 + r) * INC + ch; vc[r] = *(const v4u*)(pr + OFF_CIN); vp[r] = *(const v4u*)(pr + OFF_PG); }
#pragma unroll
        for (int r = 0; r < 8; ++r) { float cin[8], pg[8], o[8]; UNPK8(vc[r], cin); UNPK8(vp[r], pg);
#pragma unroll
            for (int e = 0; e < 8; ++e) { const float cv = bs[e] + w0[e] * p2[e] + w1[e] * p1[e] + w2[e] * cin[e]; o[e] = pg[e] * cv; p2[e] = p1[e]; p1[e] = cin[e]; }
            v4u wv; wv.x = pk2(o[0], o[1]); wv.y = pk2(o[2], o[3]); wv.z = pk2(o[4], o[5]); wv.w = pk2(o[6], o[7]); *(v4u*)(MIX + (size_t)(r0 + r) * DM + ch) = wv; }
        if (smp || t0 == 2040) { const int sq = seq_of_row(r0); float* so = F.out + (sq < 4 ? O_PCA + (size_t)((l * 4 + sq) * 2) * 1024 : O_SCA + (size_t)((l * 128 + sq - 4) * 2) * 1024) + ch;
            *(f32x4*)(so) = (f32x4){p2[0], p2[1], p2[2], p2[3]}; *(f32x4*)(so + 4) = (f32x4){p2[4], p2[5], p2[6], p2[7]};
            *(f32x4*)(so + 1024) = (f32x4){p1[0], p1[1], p1[2], p1[3]}; *(f32x4*)(so + 1028) = (f32x4){p1[4], p1[5], p1[6], p1[7]}; }
    }
}

constexpr int CW_B2CNT = 8192;
__device__ __forceinline__ void b2_phase(const Frame& F, int l) {
    const bf16* PROJ = (const bf16*)(F.ws + WS_PROJ); bf16* MIX = (bf16*)(F.ws + WS_MIX);
    const unsigned* HP = (const unsigned*)(F.ws + WS_HLOC);
    const float* SUMA = (const float*)(F.ws + WS_SUMA); const float* SUMH = (const float*)(F.ws + WS_SUMH);
    const float* SLH = inptr(F, I_SLH);
    gu32* ctr = F.ctl + CW_B2CNT + 64 * l;
    for (;;) {
        if (F.tid == 0) F.MISC[0] = __hip_atomic_fetch_add(ctr, 1u, RLX_AGENT);
        __syncthreads();
        const int blk = (int)F.MISC[0];
        __syncthreads();
        if (blk >= 288 + 288) break;
        if (blk >= 288) { mixa_item(F, l, (blk - 288) * 512 + F.tid); continue; }
        const int item = blk * 512 + F.tid;
        const int c = item >> 10, rq = (item >> 8) & 3, ch = 8 * (item & 255); const bool smp = c >= 128;
        float hin[8];
#pragma unroll
        for (int e = 0; e < 8; ++e) hin[e] = 0.f;
        if (!smp) { const int cc = c & 31; const float* sa = SUMA + (size_t)(c - cc) * 2048 + ch; const float* sh = SUMH + (size_t)(c - cc) * 2048 + ch;
            int k = 0;
            for (; k + 4 <= cc; k += 4) { f32x4 a0[4], a1[4], h0[4], h1[4];
#pragma unroll
                for (int u = 0; u < 4; ++u) { a0[u] = *(const f32x4*)(sa + (size_t)(k + u) * 2048); a1[u] = *(const f32x4*)(sa + (size_t)(k + u) * 2048 + 4); h0[u] = *(const f32x4*)(sh + (size_t)(k + u) * 2048); h1[u] = *(const f32x4*)(sh + (size_t)(k + u) * 2048 + 4); }
#pragma unroll
                for (int u = 0; u < 4; ++u)
#pragma unroll
                    for (int e = 0; e < 4; ++e) { hin[e] = a0[u][e] * hin[e] + h0[u][e]; hin[4 + e] = a1[u][e] * hin[4 + e] + h1[u][e]; } }
            for (; k < cc; ++k) { const f32x4 a0 = *(const f32x4*)(sa + (size_t)k * 2048), a1 = *(const f32x4*)(sa + (size_t)k * 2048 + 4), h0 = *(const f32x4*)(sh + (size_t)k * 2048), h1 = *(const f32x4*)(sh + (size_t)k * 2048 + 4);
#pragma unroll
                for (int e = 0; e < 4; ++e) { hin[e] = a0[e] * hin[e] + h0[e]; hin[4 + e] = a1[e] * hin[4 + e] + h1[e]; } } }
        for (int rb = 0; rb < 4; ++rb) {
            if (smp && (rb & 1) == 0) { const int b = 8 * (c - 128) + ((16 * rq + 4 * rb) >> 3); const float* st = SLH + (size_t)(l * 128 + b) * 2048 + ch; const f32x4 s0 = *(const f32x4*)st, s1 = *(const f32x4*)(st + 4);
#pragma unroll
                for (int e = 0; e < 4; ++e) { hin[e] = s0[e]; hin[4 + e] = s1[e]; } }
            v4u hp0[4], hp1[4], vg[4];
#pragma unroll
            for (int u = 0; u < 4; ++u) { const int row = c * 64 + 16 * rq + 4 * rb + u; const size_t o = (size_t)row * 2048 + ch;
                hp0[u] = *(const v4u*)(HP + o); hp1[u] = *(const v4u*)(HP + o + 4);
                vg[u] = *(const v4u*)(PROJ + (size_t)row * INC + OFF_BG + ch); }
#pragma unroll
            for (int u = 0; u < 4; ++u) { const int r = 16 * rq + 4 * rb + u, row = c * 64 + r; float bg[8], hv[8], ov[8]; UNPK8(vg[u], bg);
                hv[0] = bflo(hp0[u].x) + bfhi(hp0[u].x) * hin[0]; hv[1] = bflo(hp0[u].y) + bfhi(hp0[u].y) * hin[1]; hv[2] = bflo(hp0[u].z) + bfhi(hp0[u].z) * hin[2]; hv[3] = bflo(hp0[u].w) + bfhi(hp0[u].w) * hin[3];
                hv[4] = bflo(hp1[u].x) + bfhi(hp1[u].x) * hin[4]; hv[5] = bflo(hp1[u].y) + bfhi(hp1[u].y) * hin[5]; hv[6] = bflo(hp1[u].z) + bfhi(hp1[u].z) * hin[6]; hv[7] = bflo(hp1[u].w) + bfhi(hp1[u].w) * hin[7];
#pragma unroll
                for (int e = 0; e < 8; ++e) ov[e] = hv[e] * silu(bg[e]);
                v4u wv; wv.x = pk2(ov[0], ov[1]); wv.y = pk2(ov[2], ov[3]); wv.z = pk2(ov[4], ov[5]); wv.w = pk2(ov[6], ov[7]); *(v4u*)(MIX + (size_t)row * DM + 1024 + ch) = wv;
                bool last; float* so;
                if (smp) { last = (r & 7) == 7; so = F.out + O_SH + (size_t)(l * 128 + 8 * (c - 128) + (r >> 3)) * 2048 + ch; }
                else { last = ((c & 31) == 31) && r == 63; so = F.out + O_PH + (size_t)(l * 4 + (c >> 5)) * 2048 + ch; }
                if (last) { *(f32x4*)so = (f32x4){hv[0], hv[1], hv[2], hv[3]}; *(f32x4*)(so + 4) = (f32x4){hv[4], hv[5], hv[6], hv[7]}; } }
        }
    }
}


__device__ __forceinline__ void stream_probe(const Frame& F, int mode) {
    const float* W = inptr(F, I_WADA); const int tid = F.tid; const int b = blockIdx.x;
    f32x4 acc = (f32x4){0.f, 0.f, 0.f, 0.f}; f32x4 va[8], vb[8];
    size_t base; unsigned step;
    if (mode == 0) { base = (size_t)b * 393216 + 4 * tid; step = 2048; }
    else if (mode == 1) { const int l = b >> 7, r = b & 127, nb = r & 31, kc = r >> 5; const int row = tid / 96, c = tid % 96;
        base = (size_t)l * 4096 * MODW + (size_t)(kc * 1024 + (row < 5 ? row : 4)) * MODW + nb * 384 + 4 * c; step = 5 * MODW; }
    else { const int l = b >> 7, cb = b & 127; const int row = tid / 24, c = tid % 24;
        base = (size_t)l * 4096 * MODW + (size_t)(row < 21 ? row : 20) * MODW + cb * 96 + 4 * c; step = 21 * MODW; }
    const int nload = mode == 0 ? 192 : (mode == 1 ? 200 : 192);
    const float* p = W + base;
#define SP_LOAD(v, i0) do { _Pragma("unroll") for (int j = 0; j < 8; ++j) { const int ii = (i0) + j < nload ? (i0) + j : nload - 1; v[j] = __builtin_nontemporal_load((const f32x4*)(p + (size_t)ii * step)); } } while (0)
#define SP_SUM(v) do { _Pragma("unroll") for (int j = 0; j < 8; ++j) acc += v[j]; } while (0)
    SP_LOAD(va, 0);
    for (int i = 0; i < nload; i += 16) { SP_LOAD(vb, i + 8); SP_SUM(va); SP_LOAD(va, i + 16); SP_SUM(vb); }
#undef SP_LOAD
#undef SP_SUM
    if (acc.x + acc.y + acc.z + acc.w == 123.456789f) F.out[0] = 1.0f;
}
#define PHASE_FRAME() Frame Fp = F; Fp.ws = launder(F.ws); Fp.out = launder(F.out);
__device__ __forceinline__ void run_pre(const Frame& F) { PHASE_FRAME()
    const float* cp = inptr(Fp, I_CP); const float* cs = inptr(Fp, I_CS); bf16* CB = (bf16*)(Fp.ws + WS_CBF);
    for (int i = blockIdx.x * 512 + Fp.tid; i < 144 * 1024; i += Fp.G * 512) { const int row = i >> 10, c4 = (i & 1023) * 4;
        f32x4 v = (f32x4){0.f, 0.f, 0.f, 0.f}; if (row < NSEQ) v = *(const f32x4*)((row < 4 ? cp + (size_t)row * 4096 : cs + (size_t)(row - 4) * 4096) + c4);
        u32x2 o; o.x = pk2(v.x, v.y); o.y = pk2(v.z, v.w); *(u32x2*)(CB + (size_t)(c4 >> 6) * 9216 + row * 64 + (c4 & 63)) = o; }
}
__device__ __forceinline__ void run_p0(const Frame& F) { PHASE_FRAME()
    if (F.G == 256) { adaln_task(Fp, (int)blockIdx.x >> 7, (int)blockIdx.x & 127); if (PROBE_DUP & 64) { adaln_task_t<PROBE_ADA>(Fp, (int)blockIdx.x >> 7, (int)blockIdx.x & 127); adaln_task_t<PROBE_ADA>(Fp, (int)blockIdx.x >> 7, (int)blockIdx.x & 127); adaln_task_t<PROBE_ADA>(Fp, (int)blockIdx.x >> 7, (int)blockIdx.x & 127); } }
    else for (int t = blockIdx.x; t < 256; t += F.G) adaln_task(Fp, t >> 7, t & 127);
    __syncthreads();
    if (PROBE_DUP & 16384) { stream_probe(Fp, 0); stream_probe(Fp, 0); stream_probe(Fp, 0); } if (PROBE_DUP & 32768) { stream_probe(Fp, 1); stream_probe(Fp, 1); stream_probe(Fp, 1); } if (PROBE_DUP & 65536) { stream_probe(Fp, 2); stream_probe(Fp, 2); stream_probe(Fp, 2); }
    tr_run(Fp, 0, 5, blockIdx.x * NWAVES + Fp.wave, Fp.G * NWAVES);
    tr_run(Fp, 1, 4, blockIdx.x * NWAVES + Fp.wave, Fp.G * NWAVES);
    if (PROBE_DUP & 128) { __syncthreads(); tr_run(Fp, 0, 5, blockIdx.x * NWAVES + Fp.wave, Fp.G * NWAVES); __syncthreads(); tr_run(Fp, 0, 5, blockIdx.x * NWAVES + Fp.wave, Fp.G * NWAVES); __syncthreads(); tr_run(Fp, 0, 5, blockIdx.x * NWAVES + Fp.wave, Fp.G * NWAVES); }
    __syncthreads();
    if ((int)blockIdx.x >= 192) s5_mats(Fp, 0, (int)blockIdx.x - 192);
}
__device__ __forceinline__ void run_norm0(const Frame& F) { PHASE_FRAME() norm_phase<false, false>(Fp, inptr(Fp, I_XP), inptr(Fp, I_XS), 0, 0, nullptr, nullptr, nullptr); }
template <int l> __device__ __forceinline__ void run_gemm1(const Frame& F) { PHASE_FRAME()
    const bool side = (F.G == 256);
    if (!side || (int)blockIdx.x < 240) {
        pg8::Gemm g{(const bf16*)(Fp.ws + WS_HP), (const bf16*)(Fp.ws + WS_WINTP) + (size_t)l * 10240 * LDK, MROWS, INC, LDK}; pg8::StaticOrder S; S.init(MROWS, INC, side ? 240 : F.G, (int)blockIdx.x, DM);
        EpiProj E{(bf16*)(Fp.ws + WS_PROJ)};
        pg8::gemm_phase<EpiProj, pg8::StaticOrder, GEMM1_ALIGN, GEMM1_SP2>(F.lds + RING_OFF, g, S, E);
        if (!side) { tr_run(Fp, l, 2, blockIdx.x * NWAVES + Fp.wave, Fp.G * NWAVES); if (l == 0) tr_run(Fp, 1, 1, blockIdx.x * NWAVES + Fp.wave, Fp.G * NWAVES); }
    } else {
        const int widx = ((int)blockIdx.x - 240) * NWAVES + Fp.wave;
        tr_run(Fp, l, 2, widx, 16 * NWAVES);
        if (l == 0) tr_run(Fp, 1, 1, widx, 16 * NWAVES);
        if (PROBE_DUP & 4096) { __syncthreads(); tr_run(Fp, l, 2, widx, 16 * NWAVES); if (l == 0) tr_run(Fp, 1, 1, widx, 16 * NWAVES); }
        __syncthreads();
        if (l == 1) for (int g = (int)blockIdx.x - 240; g < 64; g += 16) s5_mats(Fp, 1, g);
    }
    __syncthreads();
}
template <int l> __device__ __forceinline__ void run_mix1(const Frame& F) { PHASE_FRAME() s5_phase(Fp, l); if (PROBE_DUP & 256) { s5_phase(Fp, l); } b1_phase(Fp, l); if (PROBE_DUP & 512) { b1_phase(Fp, l); b1_phase(Fp, l); b1_phase(Fp, l); } }
template <int l> __device__ __forceinline__ void run_mix2(const Frame& F) { PHASE_FRAME()
    if ((int)blockIdx.x < 144) {
        pg8::Gemm g{(const bf16*)(Fp.ws + WS_YG), (const bf16*)(Fp.ws + WS_WGLUT) + (size_t)l * 1024 * 1024, MROWS, 1024, 1024}; pg8::StaticOrder S; S.init(MROWS, 1024, 144, (int)blockIdx.x, 1024);
        EpiGlu E{(const bf16*)(Fp.ws + WS_YG), (const bf16*)(Fp.ws + WS_PROJ), inptr(Fp, I_BGLU) + l * 1024, (bf16*)(Fp.ws + WS_MIX)};
        pg8::gemm_phase<EpiGlu, pg8::StaticOrder, true, true>(F.lds + RING_OFF, g, S, E);
    }
    b2_phase(Fp, l);
}
template <int l> __device__ __forceinline__ void run_gemm2(const Frame& F) { PHASE_FRAME()
    bf16* X1 = (bf16*)(Fp.ws + WS_X1); const float* MOD = (const float*)(Fp.ws + WS_MOD);
    pg8::Gemm g{(const bf16*)(Fp.ws + WS_MIX), (const bf16*)(Fp.ws + WS_WOUTT) + (size_t)l * 4096 * 4096, MROWS, DM, DM}; Gemm2Order S; S.init(F.G, (int)blockIdx.x);
    if (l == 0) { EpiResGate<false> E{inptr(Fp, I_XP), inptr(Fp, I_XS), X1, MOD + 2 * DM, (bf16*)(Fp.ws + WS_PCUM)};
        pg8::gemm_phase<EpiResGate<false>, Gemm2Order, true, true>(F.lds + RING_OFF, g, S, E); }
    else { EpiResGate<true> E{X1, X1 + (size_t)NPROMPT * DM, (bf16*)(Fp.ws + WS_H), MOD + (size_t)NSEQ * MODW + 2 * DM, (bf16*)(Fp.ws + WS_PCUM)};
        pg8::gemm_phase<EpiResGate<true>, Gemm2Order, true, true>(F.lds + RING_OFF, g, S, E); }
}
template <int l> __device__ __forceinline__ void run_norm(const Frame& F) { PHASE_FRAME() bf16* X1 = (bf16*)(Fp.ws + WS_X1);
    const bf16* part = (const bf16*)(Fp.ws + WS_PCUM); const float* gate = (const float*)(Fp.ws + WS_MOD) + (size_t)l * NSEQ * MODW + 2 * DM;
    if (l == 0) norm_phase<true, false>(Fp, X1, inptr(Fp, I_XS), 0, 1, part, gate, X1 + (size_t)NPROMPT * DM);
    else norm_phase<true, true>(Fp, Fp.ws + WS_H, X1 + (size_t)NPROMPT * DM, 1, 0, part, gate, nullptr); }
#define DUP(bit, call) do { call; if ((PROBE_DUP >> (bit)) & 1) { call; } } while (0)
template <int l> __device__ __forceinline__ void layer_program(const Frame& F, const XcdBarrier& bar, int lo, int hi) {
#define IN(k) (lo <= (k) && (k) < hi)
#define SEAM(k) do { if (IN(k) && IN((k) + 1)) { xcd_barrier(bar); if (PROBE_DUP & 2048) xcd_barrier(bar); } } while (0)
    const int pb = 2 + 5 * l;
    if (IN(pb)) DUP(2, run_gemm1<l>(F));
    SEAM(pb);
    if (IN(pb + 1)) DUP(3, run_mix1<l>(F));
    SEAM(pb + 1);
    if (IN(pb + 2)) DUP(4, run_mix2<l>(F));
    SEAM(pb + 2);
    if (IN(pb + 3)) { run_gemm2<l>(F); if ((PROBE_DUP >> 5) & 1) { run_gemm2<l>(F); run_gemm2<l>(F); run_gemm2<l>(F); } }
    SEAM(pb + 3);
    if (IN(pb + 4)) { run_norm<l>(F); if (l == 0 && ((PROBE_DUP >> 1) & 1)) run_norm<l>(F); }
    SEAM(pb + 4);
#undef IN
#undef SEAM
}
struct Args { const float* in[34]; float* out; unsigned char* ws; int ph_lo, ph_hi; };
__global__ void __launch_bounds__(NWAVES * 64, 2) mega_fwd(Args args) {
    extern __shared__ __attribute__((aligned(16))) unsigned char lds[];
    Frame F;
    F.lds = (LAS unsigned char*)lds; F.MISC = (volatile LAS unsigned*)(F.lds + MISC_OFF);
    F.tid = threadIdx.x; F.lane = F.tid & 63; F.wave = __builtin_amdgcn_readfirstlane(F.tid >> 6); F.G = gridDim.x;
    F.out = args.out; F.ws = args.ws; F.ctl = (gu32*)(args.ws + WS_CTL);
    if (F.tid < 128) ((LAS unsigned*)(F.lds + LDSCTL_OFF))[F.tid] = 0u;
    if (F.tid >= 128 && F.tid < 128 + 34) { const __attribute__((address_space(4))) unsigned long long* ka = (const __attribute__((address_space(4))) unsigned long long*)__builtin_amdgcn_kernarg_segment_ptr();
        ((LAS unsigned long long*)(F.lds + PTR_OFF))[F.tid - 128] = ka[F.tid - 128]; }
    __syncthreads();
    XcdBarrier bar; bar.bar = (unsigned*)(F.ctl + CW_BAR); bar.x = 0; bar.st = nullptr;
    if (N_LAUNCHES == 1) bar = xcd_barrier_post((unsigned*)(F.ctl + CW_BAR), F.MISC + 8);
    const int lo = args.ph_lo, hi = args.ph_hi;
#define IN(k) (lo <= (k) && (k) < hi)
#define SEAM(k) do { if (IN(k) && IN((k) + 1)) { xcd_barrier(bar); if (PROBE_DUP & 2048) xcd_barrier(bar); } } while (0)
    if (IN(0)) { run_pre(F); if (N_LAUNCHES == 1) xcd_barrier(bar); run_p0(F); if (PROBE_DUP & 1) { run_p0(F); run_p0(F); run_p0(F); } }
    SEAM(0);
    if (IN(1)) DUP(1, run_norm0(F));
    SEAM(1);
    layer_program<0>(F, bar, lo, hi);
    layer_program<1>(F, bar, lo, hi);
#undef IN
#undef SEAM
}

extern "C" void kernel_launch(void* const* d_in, const int* in_sizes, int n_in, void* d_out, int out_size, void* d_ws, size_t ws_size, hipStream_t stream) {
    static int grid = 0;
    if (grid == 0) {
        if (n_in != 34 || out_size != (int)O_END || ws_size < WS_END) { fprintf(stderr, "kernel_launch: unexpected shapes: n_in %d out %d ws %zu\n", n_in, out_size, ws_size); grid = -1; return; }
        int dev = 0, cus = 0, per_cu = 0;
        if (hipGetDevice(&dev) != hipSuccess || hipDeviceGetAttribute(&cus, hipDeviceAttributeMultiprocessorCount, dev) != hipSuccess) { grid = -1; return; }
        if (hipFuncSetAttribute((const void*)mega_fwd, hipFuncAttributeMaxDynamicSharedMemorySize, LDS_BYTES) != hipSuccess) { fprintf(stderr, "kernel_launch: hipFuncSetAttribute failed\n"); grid = -1; return; }
        if (hipOccupancyMaxActiveBlocksPerMultiprocessor(&per_cu, (const void*)mega_fwd, NWAVES * 64, LDS_BYTES) != hipSuccess || per_cu < 1)
            fprintf(stderr, "kernel_launch: occupancy query reports %d workgroups per CU\n", per_cu);
        (void)hipGetLastError();
        if (cus < 256) { fprintf(stderr, "kernel_launch: this kernel needs 256 CUs (one persistent workgroup each); found %d\n", cus); grid = -1; return; }
        grid = 256;
    }
    if (grid < 0) return;
    if (hipMemsetAsync((char*)d_ws + WS_CTL, 0, CTL_ZERO_BYTES, stream) != hipSuccess) { fprintf(stderr, "kernel_launch: memset failed\n"); return; }
    Args a{};
    for (int i = 0; i < 34; ++i) a.in[i] = (const float*)d_in[i];
    a.out = (float*)d_out; a.ws = (unsigned char*)d_ws;
    if (N_LAUNCHES == 1) { a.ph_lo = 0; a.ph_hi = N_PHASES; hipLaunchKernelGGL(mega_fwd, dim3(grid), dim3(NWAVES * 64), LDS_BYTES, stream, a); }
    else for (int p = 0; p < N_PHASES; ++p) { a.ph_lo = p; a.ph_hi = p + 1; hipLaunchKernelGGL(mega_fwd, dim3(grid), dim3(NWAVES * 64), LDS_BYTES, stream, a); }
    const hipError_t le = hipPeekAtLastError();
    if (le != hipSuccess) fprintf(stderr, "kernel_launch: launch failed: %s\n", hipGetErrorName(le));
}
```

```cpp
#include <hip/hip_runtime.h>
#include <cstdio>
#include <cstdint>
#include <hip/hip_runtime.h>
#include <cstdio>
#include <cstdint>
namespace pg8 {
#define PG8_LAS __attribute__((address_space(3)))
typedef unsigned short bf16_t;
typedef short bf16x8 __attribute__((ext_vector_type(8)));
typedef float f32x4 __attribute__((ext_vector_type(4)));
typedef unsigned u32x4 __attribute__((ext_vector_type(4)));
constexpr int BM = 256, BK = 64, HALF = 128, HTB = HALF * BK * 2  , STAGE_BYTES = 8 * HTB, NXCD = 8, WGM = 8;

__host__ __device__ __forceinline__ int lds_byte(int r, int c) { const int st = (r >> 4) * 2 + (c >> 5), rr = r & 15, cc = c & 31, ob = rr * 64 + cc * 2; return st * 1024 + (ob ^ (((ob >> 9) & 1) << 5)); }
__host__ __device__ __forceinline__ void stage_rc(int b, int& R, int& C) { const int st = b / 1024, sb = b % 1024, swz = sb ^ (((sb >> 9) & 1) << 5); R = (st >> 1) * 16 + swz / 64; C = (st & 1) * 32 + (swz % 64) / 2; }
__host__ __device__ __forceinline__ int perm32(int rho) { const int n = rho >> 4, i = rho & 15; return 8 * (i >> 2) + 4 * n + (i & 3); }

struct Unit { int pm, pn, kt0, nkt; };
struct Gemm { const bf16_t* A; const bf16_t* Bt; int M, N, K; };

struct StaticOrder {
    int nM, nN, nwg, G, c, nkt;
    __host__ __device__ void init(int M, int N, int G_, int c_, int K_) { nM = M / BM; nN = N / BM; nwg = nM * nN; G = G_; c = c_; nkt = K_ / BK; }
    __host__ __device__ bool next(int i, Unit& u) const {
        const long L = (long)i * G + c; if (L >= nwg) return false;
        int wgid = (int)L; { const int q = nwg / NXCD, r = nwg % NXCD, xcd = wgid % NXCD, off = wgid / NXCD; wgid = (xcd < r ? xcd * (q + 1) : r * (q + 1) + (xcd - r) * q) + off; }
        const int nig = WGM * nN, gid = wgid / nig, fm = gid * WGM, gsz = (nM - fm) < WGM ? (nM - fm) : WGM;
        u.pm = fm + ((wgid % nig) % gsz); u.pn = (wgid % nig) / gsz; u.kt0 = 0; u.nkt = nkt; return true;
    }
    __device__ __forceinline__ void a_ready(const Unit&) const {}
    __device__ __forceinline__ void done(const Unit&) const {}
};

__device__ __forceinline__ unsigned cvt_pk_bf16(float lo, float hi) { unsigned r; asm volatile("v_cvt_pk_bf16_f32 %0, %1, %2" : "=v"(r) : "v"(lo), "v"(hi)); return r; }
template <class Epi, class Sched, bool ALIGN_EPI = false, bool SP2 = false>
__device__ __forceinline__ void gemm_phase(PG8_LAS unsigned char* lds, const Gemm g, const Sched& S, const Epi& E) {
    const int tid = threadIdx.x, wid = __builtin_amdgcn_readfirstlane(tid >> 6), lane = tid & 63, wr = wid >> 2, wc = wid & 3, fr = lane & 15, fq = lane >> 4;
    const int K = g.K;
    unsigned voffA[2], voffB[2];
#pragma unroll
    for (int i = 0; i < 2; ++i) { int R, C; stage_rc(tid * 16 + i * 8192, R, C); const int Rb = Epi::PERM ? ((R & ~31) + perm32(R & 31)) : R;
        voffA[i] = (unsigned)(R * K + C) * 2u; voffB[i] = (unsigned)(Rb * K + C) * 2u; }
    const size_t kstep = (size_t)(BK * 2);
    const size_t hstep = (size_t)HALF * K * 2;
    const size_t tstep = 2 * hstep;
    const unsigned ldsw = (unsigned)wid * 1024u;
    const int aoff = lds_byte(wr * 64 + fr, fq * 8), boff = lds_byte(wc * 32 + fr, fq * 8);
#define PG8_SA(b, h) (((b) * 2 + (h)) * HTB)
#define PG8_SB(b, h) ((4 + (b) * 2 + (h)) * HTB)
#define PG8_STAGE(bufoff, gbase, voff) do { _Pragma("unroll") for (int _i = 0; _i < 2; ++_i) \
        __builtin_amdgcn_global_load_lds((const unsigned*)((const char*)(gbase) + (voff)[_i]), (PG8_LAS unsigned*)(lds + (bufoff) + ldsw + _i * 8192), 16, 0, 0); } while (0)
#define PG8_LDA(dst, b, h) do { _Pragma("unroll") for (int m = 0; m < 4; ++m) _Pragma("unroll") for (int k = 0; k < 2; ++k) dst[m][k] = *(const PG8_LAS bf16x8*)(lds + PG8_SA(b, h) + aoff + m * 2048 + k * 1024); } while (0)
#define PG8_LDB(dst, b, h) do { _Pragma("unroll") for (int n = 0; n < 2; ++n) _Pragma("unroll") for (int k = 0; k < 2; ++k) dst[n][k] = *(const PG8_LAS bf16x8*)(lds + PG8_SB(b, h) + boff + n * 2048 + k * 1024); } while (0)
#define PG8_MMA(ai, bj, At, Bt) do { __builtin_amdgcn_s_setprio(1); _Pragma("unroll") for (int m = 0; m < 4; ++m) _Pragma("unroll") for (int n = 0; n < 2; ++n) _Pragma("unroll") for (int k = 0; k < 2; ++k) \
        acc[ai][bj][m][n] = __builtin_amdgcn_mfma_f32_16x16x32_bf16(Bt[n][k], At[m][k], acc[ai][bj][m][n], 0, 0, 0); __builtin_amdgcn_s_setprio(0); } while (0)
#define PG8_WAIT_V(n) asm volatile("s_waitcnt vmcnt(" #n ")" ::: "memory")
#define PG8_WAIT_L(n) asm volatile("s_waitcnt lgkmcnt(" #n ")" ::: "memory")
#define PG8_BAR __builtin_amdgcn_s_barrier()
#define PG8_SCHED __builtin_amdgcn_sched_barrier(0)
    Unit cur, nxt; int ui = 0;
    if (!S.next(0, cur)) return;
    f32x4 acc[2][2][4][2];
#pragma unroll
    for (int a = 0; a < 2; ++a)
#pragma unroll
        for (int b = 0; b < 2; ++b)
#pragma unroll
            for (int m = 0; m < 4; ++m)
#pragma unroll
                for (int n = 0; n < 2; ++n) acc[a][b][m][n] = (f32x4){0.f, 0.f, 0.f, 0.f};
    bf16x8 At[4][2], B0[2][2], B1[2][2];
    const char* cA = (const char*)g.A + (size_t)cur.pm * tstep + (size_t)cur.kt0 * kstep; const char* cB = (const char*)g.Bt + (size_t)cur.pn * tstep + (size_t)cur.kt0 * kstep;
    S.a_ready(cur);
    if constexpr (SP2) {
        PG8_STAGE(PG8_SB(0, 0), cB, voffB); PG8_STAGE(PG8_SB(0, 1), cB + hstep, voffB); PG8_STAGE(PG8_SA(0, 0), cA, voffA); PG8_STAGE(PG8_SA(0, 1), cA + hstep, voffA);
        if (wr == 1) PG8_BAR;
        PG8_WAIT_V(2); PG8_BAR;
        PG8_STAGE(PG8_SB(1, 0), cB + kstep, voffB); PG8_STAGE(PG8_SA(1, 0), cA + kstep, voffA); PG8_STAGE(PG8_SB(1, 1), cB + hstep + kstep, voffB);
        PG8_WAIT_V(6); PG8_BAR;
    } else {
        PG8_STAGE(PG8_SB(0, 0), cB, voffB); PG8_STAGE(PG8_SA(0, 0), cA, voffA); PG8_STAGE(PG8_SB(0, 1), cB + hstep, voffB); PG8_STAGE(PG8_SA(0, 1), cA + hstep, voffA);
        if (wr == 1) PG8_BAR;
        PG8_WAIT_V(4); PG8_BAR;
        PG8_STAGE(PG8_SB(1, 0), cB + kstep, voffB); PG8_STAGE(PG8_SA(1, 0), cA + kstep, voffA); PG8_STAGE(PG8_SB(1, 1), cB + hstep + kstep, voffB);
        PG8_WAIT_V(6); PG8_BAR;
    }
    for (;;) {
        const bool has_next = S.next(ui + 1, nxt);
        const char* nA = has_next ? (const char*)g.A + (size_t)nxt.pm * tstep + (size_t)nxt.kt0 * kstep : cA; const char* nB = has_next ? (const char*)g.Bt + (size_t)nxt.pn * tstep + (size_t)nxt.kt0 * kstep : cB;
        const int nt = cur.nkt;
        for (int t = 0; t < nt; t += 2) {
            const bool last = (t == nt - 2);
            const char* a1 = cA + (size_t)(t + 1) * kstep;
            const char* a2 = last ? nA : cA + (size_t)(t + 2) * kstep; const char* b2 = last ? nB : cB + (size_t)(t + 2) * kstep;
            const char* a3 = a2 + kstep; const char* b3 = b2 + kstep;
            if (last && has_next) S.a_ready(nxt);
            if constexpr (SP2) {
            PG8_LDB(B0, 0, 0); PG8_LDB(B1, 0, 1); PG8_SCHED; PG8_LDA(At, 0, 0); PG8_STAGE(PG8_SA(1, 1), a1 + hstep, voffA);
            PG8_WAIT_V(8); PG8_WAIT_L(0); PG8_BAR; PG8_MMA(0, 0, At, B0); PG8_MMA(0, 1, At, B1); PG8_BAR; PG8_SCHED;
            PG8_LDA(At, 0, 1); PG8_STAGE(PG8_SB(0, 0), b2, voffB); PG8_STAGE(PG8_SB(0, 1), b2 + hstep, voffB); PG8_STAGE(PG8_SA(0, 0), a2, voffA);
            PG8_WAIT_V(8); PG8_WAIT_L(0); PG8_BAR; PG8_MMA(1, 0, At, B0); PG8_MMA(1, 1, At, B1); PG8_BAR; PG8_SCHED;
            PG8_LDB(B0, 1, 0); PG8_LDB(B1, 1, 1); PG8_SCHED; PG8_LDA(At, 1, 0); PG8_STAGE(PG8_SA(0, 1), a2 + hstep, voffA);
            PG8_WAIT_V(8); PG8_WAIT_L(0); PG8_BAR; PG8_MMA(0, 0, At, B0); PG8_MMA(0, 1, At, B1); PG8_BAR; PG8_SCHED;
            PG8_LDA(At, 1, 1); PG8_STAGE(PG8_SB(1, 0), b3, voffB); PG8_STAGE(PG8_SB(1, 1), b3 + hstep, voffB); PG8_STAGE(PG8_SA(1, 0), a3, voffA);
            PG8_WAIT_V(8); PG8_WAIT_L(0); PG8_BAR; PG8_MMA(1, 0, At, B0); PG8_MMA(1, 1, At, B1); PG8_BAR; PG8_SCHED;
            } else {
            PG8_LDB(B0, 0, 0); PG8_SCHED; PG8_LDA(At, 0, 0); PG8_STAGE(PG8_SA(1, 1), a1 + hstep, voffA);
            PG8_WAIT_L(8); PG8_BAR; PG8_WAIT_L(0); PG8_MMA(0, 0, At, B0); PG8_BAR; PG8_SCHED;
            PG8_LDB(B1, 0, 1); PG8_STAGE(PG8_SB(0, 0), b2, voffB);
            PG8_BAR; PG8_WAIT_L(0); PG8_MMA(0, 1, At, B1); PG8_BAR;
            PG8_LDA(At, 0, 1); PG8_STAGE(PG8_SA(0, 0), a2, voffA);
            PG8_BAR; PG8_WAIT_L(0); PG8_MMA(1, 0, At, B0); PG8_BAR; PG8_SCHED;
            PG8_STAGE(PG8_SB(0, 1), b2 + hstep, voffB);
            PG8_WAIT_V(6); PG8_BAR; PG8_MMA(1, 1, At, B1); PG8_BAR;
            PG8_LDB(B0, 1, 0); PG8_SCHED; PG8_LDA(At, 1, 0); PG8_STAGE(PG8_SA(0, 1), a2 + hstep, voffA);
            PG8_WAIT_L(8); PG8_BAR; PG8_WAIT_L(0); PG8_MMA(0, 0, At, B0); PG8_BAR; PG8_SCHED;
            PG8_LDB(B1, 1, 1); PG8_STAGE(PG8_SB(1, 0), b3, voffB);
            PG8_BAR; PG8_WAIT_L(0); PG8_MMA(0, 1, At, B1); PG8_BAR;
            PG8_LDA(At, 1, 1); PG8_STAGE(PG8_SA(1, 0), a3, voffA);
            PG8_BAR; PG8_WAIT_L(0); PG8_MMA(1, 0, At, B0); PG8_BAR; PG8_SCHED;
            PG8_STAGE(PG8_SB(1, 1), b3 + hstep, voffB);
            PG8_WAIT_V(6); PG8_BAR; PG8_MMA(1, 1, At, B1); PG8_BAR;
            }
        }
        if constexpr (ALIGN_EPI) { if (wr == 0) PG8_BAR; }
        if constexpr (!Epi::AFTER_DRAIN) { E(acc, cur, wr, wc, fr, fq); S.done(cur); }
        if (!has_next) break;
#pragma unroll
        for (int a = 0; a < 2; ++a)
#pragma unroll
            for (int b = 0; b < 2; ++b)
#pragma unroll
                for (int m = 0; m < 4; ++m)
#pragma unroll
                    for (int n = 0; n < 2; ++n) acc[a][b][m][n] = (f32x4){0.f, 0.f, 0.f, 0.f};
        cur = nxt; cA = nA; cB = nB; ++ui;
        if constexpr (ALIGN_EPI) { if (wr == 1) PG8_BAR; }
    }
    PG8_WAIT_V(0);
    if constexpr (!ALIGN_EPI) { if (wr == 0) PG8_BAR; }
    PG8_BAR;
    if constexpr (Epi::AFTER_DRAIN) { E.fused(acc, cur, wr, wc, fr, fq, lds, wid, lane); S.done(cur); }
#undef PG8_SA
#undef PG8_SB
#undef PG8_STAGE
#undef PG8_LDA
#undef PG8_LDB
#undef PG8_MMA
#undef PG8_WAIT_V
#undef PG8_WAIT_L
#undef PG8_BAR
#undef PG8_SCHED
}
}
#define GAS __attribute__((address_space(1)))
#define LAS __attribute__((address_space(3)))
typedef unsigned short bf16;
typedef unsigned v4u __attribute__((ext_vector_type(4)));
typedef float f32x4 __attribute__((ext_vector_type(4)));
typedef short bf16x8 __attribute__((ext_vector_type(8)));
typedef GAS unsigned gu32;
typedef GAS unsigned long long gu64;
#define RLX_AGENT __ATOMIC_RELAXED, __HIP_MEMORY_SCOPE_AGENT
#define LDS_WAIT() asm volatile("s_waitcnt lgkmcnt(0)" ::: "memory")
#define VM_WAIT() asm volatile("s_waitcnt vmcnt(0)" ::: "memory")
__device__ __forceinline__ unsigned long long rt() { return __builtin_amdgcn_s_memrealtime(); }
typedef float f32x2_t __attribute__((ext_vector_type(2))); typedef __bf16 bf16x2_t __attribute__((ext_vector_type(2)));
__device__ __forceinline__ unsigned pk2(float lo, float hi) { const f32x2_t v = {lo, hi}; return __builtin_bit_cast(unsigned, __builtin_convertvector(v, bf16x2_t)); }
__device__ __forceinline__ unsigned f2bf(float f) { return pk2(f, 0.f) & 0xffffu; }

#define XB_TMO      128
#define XB_XCNT(j)  (256  + 64 * (j))
#define XB_XSUB(j)  (1280 + 64 * (j))
#define XB_XGEN(j)  (2304 + 64 * (j))
#define XB_TOP      3328
#define XB_TOPGEN   3392
#define XCD_BAR_WORDS 3456
#define XB_SPIN_CAP (1u << 18)

__device__ __forceinline__ unsigned xb_ld(unsigned* p)              { return __hip_atomic_load(p, __ATOMIC_RELAXED, __HIP_MEMORY_SCOPE_AGENT); }
__device__ __forceinline__ unsigned xb_add(unsigned* p, unsigned v) { return __hip_atomic_fetch_add(p, v, __ATOMIC_RELAXED, __HIP_MEMORY_SCOPE_AGENT); }
__device__ __forceinline__ unsigned xb_xcc_id() { return (unsigned)__builtin_amdgcn_s_getreg((3 << 11) | 20) & 0xFu; }
#define XB_SPIN(cond, bar) do { unsigned _sp = 0; while (cond) { __builtin_amdgcn_s_sleep(1); \
    if ((++_sp & 255u) == 0u) { if (xb_ld(&(bar)[XB_TMO])) break; if (_sp > XB_SPIN_CAP) { atomicAdd(&(bar)[XB_TMO], 1u); break; } } } } while (0)

struct XcdBarrier {
    unsigned* bar; unsigned x;
    volatile LAS unsigned* st;
};

__device__ __forceinline__ XcdBarrier xcd_barrier_post(unsigned* bar, volatile LAS unsigned* st) {
    XcdBarrier b; b.bar = bar; b.x = xb_xcc_id(); b.st = st;
    if (threadIdx.x == 0) (void)xb_add(&bar[XB_XCNT(b.x)], 1u);
    return b;
}
__device__ __forceinline__ void xcd_barrier_complete(unsigned* bar, unsigned x, unsigned& nloc, unsigned& nx) {
    const unsigned G = gridDim.x * gridDim.y * gridDim.z;
    unsigned sum, cnt, mine, sp = 0u;
    for (;;) {
        sum = 0u; cnt = 0u; mine = 0u;
#pragma unroll
        for (unsigned j = 0; j < 16; ++j) { const unsigned c = xb_ld(&bar[XB_XCNT(j)]); sum += c; cnt += (c > 0u) ? 1u : 0u; mine = (j == x) ? c : mine; }
        if (sum == G) break;
        __builtin_amdgcn_s_sleep(1);
        if ((++sp & 255u) == 0u) { if (xb_ld(&bar[XB_TMO])) break; if (sp > XB_SPIN_CAP) { atomicAdd(&bar[XB_TMO], 1u); break; } }
    }
    nloc = mine > 0u ? mine : 1u; nx = cnt > 0u ? cnt : 1u;
}

__device__ __forceinline__ void xcd_barrier(const XcdBarrier& b) {
    asm volatile("s_waitcnt vmcnt(0)" ::: "memory");
    __syncthreads();
    if (threadIdx.x == 0) {
        GAS unsigned* gbar_ = (GAS unsigned*)b.bar; asm volatile("" : "+s"(gbar_)); unsigned* bar = (unsigned*)gbar_;
        __builtin_amdgcn_s_waitcnt(0);
        unsigned nloc = b.st[0], nx = b.st[1];
        if (nloc == 0u) { unsigned bx = b.x; asm volatile("" : "+s"(bx)); xcd_barrier_complete(bar, bx, nloc, nx); b.st[0] = nloc; b.st[1] = nx; }
        const unsigned old = xb_add(&bar[XB_XSUB(b.x)], 1u);
        const unsigned gen = old / nloc;
        if (old + 1u == (gen + 1u) * nloc) {
            __builtin_amdgcn_fence(__ATOMIC_RELEASE, "agent");
            asm volatile("s_waitcnt vmcnt(0)" ::: "memory");
            const unsigned og = xb_add(&bar[XB_TOP], 1u);
            const unsigned tg = og / nx;
            if (og + 1u == (tg + 1u) * nx) xb_add(&bar[XB_TOPGEN], 1u);
            else XB_SPIN(xb_ld(&bar[XB_TOPGEN]) == tg, bar);
            __builtin_amdgcn_fence(__ATOMIC_ACQUIRE, "agent");
            xb_add(&bar[XB_XGEN(b.x)], 1u);
            asm volatile("s_waitcnt vmcnt(0)" ::: "memory");
        } else {
            XB_SPIN(xb_ld(&bar[XB_XGEN(b.x)]) == gen, bar);
            __builtin_amdgcn_fence(__ATOMIC_ACQUIRE, "agent");
            asm volatile("s_waitcnt vmcnt(0)" ::: "memory");
        }
    }
    __syncthreads();
}

constexpr int NWAVES = 8;
#ifndef MK_N_LAUNCHES
#define MK_N_LAUNCHES 1
#endif
constexpr int N_PHASES = 12;
#ifndef GEMM1_ALIGN
#define GEMM1_ALIGN false
#endif
#ifndef GEMM1_SP2
#define GEMM1_SP2 true
#endif
#ifndef PROBE_DUP
#define PROBE_DUP 0
#define PROBE_ADA 0
#endif

constexpr int N_LAUNCHES = MK_N_LAUNCHES;

constexpr int DM = 4096, MROWS = 9216, NPROMPT = 8192, NSEQ = 132, INC = 10240, MODW = 12288;
constexpr int OFF_AB = 0, OFF_AC = 1024, OFF_AX = 2048, OFF_AG = 3072, OFF_BX = 4096, OFF_BG = 6144, OFF_CU = 8192, OFF_CG = 9216;
constexpr float RMS_EPS = 1e-6f;
constexpr size_t O_Y = 0;
constexpr size_t O_PCA = (size_t)MROWS * DM;
constexpr size_t O_PCB = O_PCA + 2 * 4 * 2 * 1024;
constexpr size_t O_PH  = O_PCB + 2 * 4 * 3 * 2048;
constexpr size_t O_PRE = O_PH + 2 * 4 * 2048;
constexpr size_t O_PIM = O_PRE + 2 * 4 * 4096;
constexpr size_t O_SCA = O_PIM + 2 * 4 * 4096;
constexpr size_t O_SCB = O_SCA + 2 * 128 * 2 * 1024;
constexpr size_t O_SH  = O_SCB + 2 * 128 * 3 * 2048;
constexpr size_t O_SRE = O_SH + 2 * 128 * 2048;
constexpr size_t O_SIM = O_SRE + 2 * 128 * 4096;
constexpr size_t O_END = O_SIM + 2 * 128 * 4096;
static_assert(O_END == 42614784, "output size");
constexpr size_t MiB = 1u << 20;
constexpr size_t WS_CTL = 0, CTL_ZERO_BYTES = 1 * MiB;
constexpr size_t WS_WOUTT = 162 * MiB;
constexpr size_t WS_WGLUT = 226 * MiB;
constexpr size_t WS_WRGT = 230 * MiB;
constexpr size_t WS_WIGT = 231 * MiB;
constexpr size_t WS_S5M = 232 * MiB, S5M_STRIDE = 131072;
constexpr size_t WS_MOD = 248 * MiB;
constexpr size_t WS_H = 262 * MiB;
constexpr size_t WS_PROJ = 334 * MiB;
constexpr size_t WS_MIX = 514 * MiB;
constexpr size_t WS_X1 = 586 * MiB;
constexpr size_t WS_YG = 730 * MiB;
constexpr size_t WS_HLOC = 748 * MiB;
constexpr size_t WS_PCUM = 820 * MiB;
constexpr size_t WS_SUMA = 892 * MiB, WS_SUMH = 893 * MiB;
constexpr int LDK = 4160;
constexpr size_t WS_HP = 894 * MiB;
constexpr size_t WS_WINTP = 968 * MiB;
constexpr size_t WS_CBF = 1132 * MiB;
constexpr size_t WS_END = 1134 * MiB;
constexpr int CW_BAR = 4096;
constexpr int RING_OFF = 0;
constexpr int LDS_BYTES = 147456;
constexpr int LDSCTL_OFF = LDS_BYTES - 1024, MISC_OFF = LDSCTL_OFF + 320, PTR_OFF = LDSCTL_OFF + 512;

typedef unsigned u32x2 __attribute__((ext_vector_type(2)));
__device__ __forceinline__ float bflo(unsigned u) { return __builtin_bit_cast(float, u << 16); }
__device__ __forceinline__ float bfhi(unsigned u) { return __builtin_bit_cast(float, u & 0xffff0000u); }
__device__ __forceinline__ float fexp(float x) { return __builtin_amdgcn_exp2f(x * 1.4426950408889634f); }
__device__ __forceinline__ float sigm(float x) { return __builtin_amdgcn_rcpf(1.0f + __builtin_amdgcn_exp2f(x * -1.4426950408889634f)); }
__device__ __forceinline__ float silu(float x) { return x * sigm(x); }
__device__ __forceinline__ float gelu_tanh(float x) { return x * sigm(1.5957691216f * (x + 0.044715f * x * x * x)); }
#define UNPK8(v, f) do { f[0] = bflo((v).x); f[1] = bfhi((v).x); f[2] = bflo((v).y); f[3] = bfhi((v).y); f[4] = bflo((v).z); f[5] = bfhi((v).z); f[6] = bflo((v).w); f[7] = bfhi((v).w); } while (0)

struct Frame {
    LAS unsigned char* lds;
    volatile LAS unsigned* MISC;
    gu32* ctl;
    int tid, lane, wave, G;
    float* out;
    unsigned char* ws;
};
enum { I_XP = 0, I_XS, I_CP, I_CS, I_SCA, I_SCB, I_SLH, I_SRE, I_SIM, I_GN, I_WADA, I_BADA, I_WIN, I_WCA, I_BCA, I_WCB, I_BCB, I_WRG, I_BRG, I_WIG, I_BIG,
       I_LAM, I_S5LR, I_S5LI, I_S5DT, I_S5BR, I_S5BI, I_S5CR, I_S5CI, I_S5D, I_WGLU, I_BGLU, I_WOUT, I_GFIN };

template <class T> __device__ __forceinline__ T* launder(T* p) { GAS T* g = (GAS T*)p; asm volatile("" : "+s"(g)); return (T*)g; }
__device__ __forceinline__ const float* inptr(const Frame& F, int i) {
    volatile LAS unsigned* t = (volatile LAS unsigned*)(F.lds + PTR_OFF);
    const unsigned lo = __builtin_amdgcn_readfirstlane(t[2 * i]), hi = __builtin_amdgcn_readfirstlane(t[2 * i + 1]);
    const GAS float* g = (const GAS float*)(((unsigned long long)hi << 32) | (unsigned long long)lo); return (const float*)g;
}
__device__ __forceinline__ float wave_sum(float v) {
#pragma unroll
    for (int o = 1; o < 64; o <<= 1) v += __shfl_xor(v, o);
    return v;
}
__device__ __forceinline__ int seq_of_row(int row) { return row < NPROMPT ? (row >> 11) : 4 + ((row - NPROMPT) >> 3); }

constexpr int TR_IN_TILES = 64 * 160, TR_OUT_TILES = 64 * 64, TR_SMALL_TILES = 16 * 16 + 64 + 64;
struct TrTile { const float* src; bf16* dst; int N, K; };
__device__ __forceinline__ TrTile tr_locate(const Frame& F, int l, int which, int t) {
    const float* W; bf16* WT; int K, N; int r = t; bool found = false;
    W = nullptr; WT = nullptr; K = 128; N = 128;
    if (which & 1) { if (r < TR_IN_TILES) { W = inptr(F, I_WIN) + (size_t)l * 4096 * 10240; WT = (bf16*)(F.ws + WS_WINTP) + (size_t)l * 10240 * LDK; K = LDK; N = 10240; found = true; } else r -= TR_IN_TILES; }
    if (!found && (which & 2)) { if (r < TR_OUT_TILES) { W = inptr(F, I_WOUT) + (size_t)l * 4096 * 4096; WT = (bf16*)(F.ws + WS_WOUTT) + (size_t)l * 4096 * 4096; K = 4096; N = 4096; found = true; } else r -= TR_OUT_TILES; }
    if (!found) {
        if (r < 256) { W = inptr(F, I_WGLU) + (size_t)l * 1024 * 1024; WT = (bf16*)(F.ws + WS_WGLUT) + (size_t)l * 1024 * 1024; K = 1024; N = 1024; }
        else { r -= 256; const bool ig = r >= 64; if (ig) r -= 64; const int hd = r >> 2; r &= 3;
            W = inptr(F, ig ? I_WIG : I_WRG) + (size_t)(l * 16 + hd) * 16384; WT = (bf16*)(F.ws + (ig ? WS_WIGT : WS_WRGT)) + (size_t)(l * 16 + hd) * 16384; K = 128; N = 128; } }
    const int nblk = N >> 6, kb = r / nblk, nb = r - kb * nblk;
    int drow = 64 * nb;
    if (N == INC && nb < 64) { const int seg = nb >> 4, t = nb & 15; drow = t * 256 + (seg == 0 ? 1 : (seg == 1 ? 0 : seg)) * 64; }
    TrTile o; o.src = W + (size_t)(64 * kb) * N + 64 * nb; o.dst = WT + (size_t)drow * K + 64 * kb; o.N = N; o.K = K; return o;
}
#define TR_LOAD(v, tl) do { const float* s_ = (tl).src + (size_t)(lane >> 4) * (tl).N + 4 * (lane & 15); \
    _Pragma("unroll") for (int i = 0; i < 16; ++i) v[i] = __builtin_nontemporal_load((const f32x4*)(s_ + (size_t)(4 * i) * (tl).N)); } while (0)
#define TR_PROC(v, tl) do { \
    _Pragma("unroll") for (int i = 0; i < 16; ++i) { LAS float* d_ = T + (4 * i + (lane >> 4)) * 65 + 4 * (lane & 15); d_[0] = v[i].x; d_[1] = v[i].y; d_[2] = v[i].z; d_[3] = v[i].w; } \
    LDS_WAIT(); asm volatile("" ::: "memory"); \
    _Pragma("unroll") for (int j = 0; j < 8; ++j) { const int n_ = (lane >> 3) + 8 * j; const LAS float* s_ = T + (8 * (lane & 7)) * 65 + n_; \
        v4u o_; o_.x = pk2(s_[0], s_[65]); o_.y = pk2(s_[130], s_[195]); o_.z = pk2(s_[260], s_[325]); o_.w = pk2(s_[390], s_[455]); \
        __builtin_nontemporal_store(o_, (v4u*)((tl).dst + (size_t)n_ * (tl).K + 8 * (lane & 7))); } \
    LDS_WAIT(); asm volatile("" ::: "memory"); } while (0)
__device__ __forceinline__ void tr_run(const Frame& F, int l, int which, int widx, int wcnt) {
    const int total = ((which & 1) ? TR_IN_TILES : 0) + ((which & 2) ? TR_OUT_TILES : 0) + ((which & 4) ? TR_SMALL_TILES : 0); const int lane = F.lane;
    LAS float* T = (LAS float*)(F.lds + F.wave * 16640);
    int t = widx; if (t >= total) return;
    f32x4 va[16], vb[16];
    TrTile ta = tr_locate(F, l, which, t), tb = ta;
    TR_LOAD(va, ta);
    for (;;) {
        bool nx = (t + wcnt) < total;
        tb = tr_locate(F, l, which, nx ? t + wcnt : t); TR_LOAD(vb, tb);
        TR_PROC(va, ta);
        if (!nx) break;
        t += wcnt; nx = (t + wcnt) < total;
        ta = tr_locate(F, l, which, nx ? t + wcnt : t); TR_LOAD(va, ta);
        TR_PROC(vb, tb);
        if (!nx) break;
        t += wcnt;
    }
}

template <int PM> __device__ __forceinline__ void adaln_task_t(const Frame& F, int l, int cb) {
    const int tid = F.tid, lane = F.lane, w = F.wave, fr = lane & 15, fq = lane >> 4;
    constexpr int ABUF = (144 + 96) * 72;
    LAS bf16* L0 = (LAS bf16*)(F.lds);
    const float* W = inptr(F, I_WADA) + (size_t)l * 4096 * MODW + cb * 96;
    f32x4 acc[9]; const int ntg = w & 1, mg = w >> 1, mt0 = mg == 0 ? 0 : 1 + 2 * mg;
#pragma unroll
    for (int j = 0; j < 9; ++j) acc[j] = (f32x4){0.f, 0.f, 0.f, 0.f};
    f32x4 wv[4][4]; v4u cv[4][3];
    unsigned woff[2];
#pragma unroll
    for (int i = 0; i < 2; ++i) { const int task0 = tid + 512 * i, task = task0 < 768 ? task0 : 767, kp = task / 24, n4 = task % 24; woff[i] = (unsigned)((2 * kp) * MODW + 4 * n4); }
    const bf16* CB = (const bf16*)(F.ws + WS_CBF); unsigned coff[3];
#pragma unroll
    for (int i = 0; i < 3; ++i) { const int p0 = tid + 512 * i, p = p0 < 1152 ? p0 : 1151; coff[i] = (unsigned)(8 * p); }
#define ADA_LOADW(s, kt) do { const int kc_ = (kt) < 64 ? (kt) : 63; const float* wb_ = W + (size_t)kc_ * 64 * MODW; \
    wv[s][0] = *(const f32x4*)(wb_ + woff[0]); wv[s][1] = *(const f32x4*)(wb_ + woff[0] + MODW); \
    wv[s][2] = *(const f32x4*)(wb_ + woff[1]); wv[s][3] = *(const f32x4*)(wb_ + woff[1] + MODW); } while (0)
#define ADA_LOADC(s, kt) do { const int kc_ = (kt) < 64 ? (kt) : 63; \
    _Pragma("unroll") for (int i = 0; i < 3; ++i) cv[s][i] = *(const v4u*)(CB + kc_ * 9216 + coff[i]); } while (0)
#define ADA_WB(s, i) do { const int task = tid + 512 * (i), kp = task / 24, n4 = task % 24; LAS unsigned* bd_ = (LAS unsigned*)Bs + (4 * n4) * 36 + ((((kp >> 2) ^ (n4 >> 1)) & 7) << 2) + (kp & 3); \
    bd_[0] = pk2(wv[s][2 * (i)].x, wv[s][2 * (i) + 1].x); bd_[36] = pk2(wv[s][2 * (i)].y, wv[s][2 * (i) + 1].y); bd_[72] = pk2(wv[s][2 * (i)].z, wv[s][2 * (i) + 1].z); bd_[108] = pk2(wv[s][2 * (i)].w, wv[s][2 * (i) + 1].w); } while (0)
#define ADA_WRITE(s, kt) do { LAS bf16* As = L0 + ((kt) & 1) * ABUF; LAS bf16* Bs = As + 144 * 72; \
    ADA_WB(s, 0); if (tid < 256) ADA_WB(s, 1); \
    _Pragma("unroll") for (int i = 0; i < 3; ++i) { const int p = tid + 512 * i; if (p < 1152) *(LAS v4u*)(As + (p >> 3) * 72 + 8 * (p & 7)) = cv[s][i]; } } while (0)
#define ADA_MMA(kt) do { const LAS bf16* As = L0 + ((kt) & 1) * ABUF; const LAS bf16* Bs = As + 144 * 72; \
    if (PM == 0) { _Pragma("unroll") for (int ks = 0; ks < 2; ++ks) { bf16x8 a_[3], b_[3];     \
        _Pragma("unroll") for (int ni = 0; ni < 3; ++ni) { const int nr_ = 16 * (3 * ntg + ni) + fr; b_[ni] = *(const LAS bf16x8*)(Bs + nr_ * 72 + 8 * (((4 * ks + fq) ^ (nr_ >> 3)) & 7)); } \
        _Pragma("unroll") for (int mi = 0; mi < 2; ++mi) a_[mi] = *(const LAS bf16x8*)(As + (16 * (mt0 + mi) + fr) * 72 + 32 * ks + 8 * fq); \
        _Pragma("unroll") for (int mi = 0; mi < 2; ++mi) _Pragma("unroll") for (int ni = 0; ni < 3; ++ni) acc[3 * mi + ni] = __builtin_amdgcn_mfma_f32_16x16x32_bf16(a_[mi], b_[ni], acc[3 * mi + ni], 0, 0, 0); \
        if (mg == 0) { a_[2] = *(const LAS bf16x8*)(As + (16 * 2 + fr) * 72 + 32 * ks + 8 * fq); \
            _Pragma("unroll") for (int ni = 0; ni < 3; ++ni) acc[6 + ni] = __builtin_amdgcn_mfma_f32_16x16x32_bf16(a_[2], b_[ni], acc[6 + ni], 0, 0, 0); } } } } while (0)
#define ADA_STEP(s, kt) do { \
    ADA_LOADC(s, (kt) + 4); ADA_LOADW(s, (kt) + 4); __builtin_amdgcn_sched_barrier(0); \
    ADA_MMA(kt); \
    ADA_WRITE(((s) + 1) & 3, (kt) + 1); \
    __syncthreads(); } while (0)
    ADA_LOADC(0, 0); ADA_LOADW(0, 0); ADA_LOADC(1, 1); ADA_LOADW(1, 1); ADA_LOADC(2, 2); ADA_LOADW(2, 2); ADA_LOADC(3, 3); ADA_LOADW(3, 3);
    ADA_WRITE(0, 0); __syncthreads();
    for (int kt = 0; kt < 64; kt += 4) { ADA_STEP(0, kt); ADA_STEP(1, kt + 1); ADA_STEP(2, kt + 2); ADA_STEP(3, kt + 3); }
#undef ADA_WRITE
#undef ADA_MMA
#undef ADA_LOADW
#undef ADA_LOADC
#undef ADA_WB
#undef ADA_STEP
    float* MOD = (float*)(F.ws + WS_MOD); const float* bada = inptr(F, I_BADA) + (size_t)l * MODW; const int n0 = cb * 96;
#pragma unroll
    for (int mi = 0; mi < 3; ++mi) { if (PM == 0 && (mi < 2 || mg == 0)) {
#pragma unroll
        for (int ni = 0; ni < 3; ++ni) { const int mt = mt0 + mi, nt = 3 * ntg + ni; const int n = n0 + 16 * nt + fr; const float bb = bada[n];
#pragma unroll
            for (int rg = 0; rg < 4; ++rg) { const int row = 16 * mt + 4 * fq + rg; if (row < NSEQ) MOD[(size_t)(l * NSEQ + row) * MODW + n] = acc[3 * mi + ni][rg] + bb; } } } }
    __syncthreads();
}

__device__ __forceinline__ void adaln_task(const Frame& F, int l, int cb) { adaln_task_t<0>(F, l, cb); }
__device__ __forceinline__ void s5_mats(const Frame& F, int l, int g) {
    LAS float* PWr = (LAS float*)F.lds;
    LAS float* PWi = PWr + 9 * 64;
    LAS float* BBr = PWi + 9 * 64;
    LAS float* BBi = BBr + 1024;
    LAS float* CR = BBi + 1024;
    LAS float* CI = CR + 1040;
    LAS float* KT = CI + 1040;
    LAS float* DD = KT + 2048;
    const int tid = F.tid; const int lg = l * 64 + g;
    unsigned char* mb = F.ws + WS_S5M + (size_t)lg * S5M_STRIDE;
    const float* pDT = inptr(F, I_S5DT); const float* pLR = inptr(F, I_S5LR); const float* pLI = inptr(F, I_S5LI); const float* pBR = inptr(F, I_S5BR); const float* pBI = inptr(F, I_S5BI);
    const float* pCR = inptr(F, I_S5CR); const float* pCI = inptr(F, I_S5CI); const float* pD = inptr(F, I_S5D);
    if (tid < 64) {
        const int p = tid; const float dt = expf(pDT[lg]); const float lre = pLR[lg * 64 + p], lim = pLI[lg * 64 + p];
        f32x4 br4[4], bi4[4];
#pragma unroll
        for (int q = 0; q < 4; ++q) { br4[q] = *(const f32x4*)(pBR + (size_t)(lg * 64 + p) * 16 + 4 * q); bi4[q] = *(const f32x4*)(pBI + (size_t)(lg * 64 + p) * 16 + 4 * q); }
        const float mag = expf(lre * dt), ang = lim * dt; const float ar = mag * cosf(ang), ai = mag * sinf(ang);
        const float nr = ar - 1.0f, den = lre * lre + lim * lim; const float fr_ = (nr * lre + ai * lim) / den, fi_ = (ai * lre - nr * lim) / den;
        float pr = 1.f, pi = 0.f;
        for (int k = 0; k < 9; ++k) { PWr[k * 64 + p] = pr; PWi[k * 64 + p] = pi; const float t = pr * ar - pi * ai; pi = pr * ai + pi * ar; pr = t; }
#pragma unroll
        for (int j = 0; j < 16; ++j) { const float bre = br4[j >> 2][j & 3], bim = bi4[j >> 2][j & 3];
            BBr[p * 16 + j] = fr_ * bre - fi_ * bim; BBi[p * 16 + j] = fr_ * bim + fi_ * bre; }
        float* A8P = (float*)(mb + 98304); const float a8r = PWr[8 * 64 + p], a8i = PWi[8 * 64 + p]; float qr = a8r, qi = a8i;
        for (int k = 0; k < 4; ++k) { A8P[k * 128 + p] = qr; A8P[k * 128 + 64 + p] = qi; const float t = qr * a8r - qi * a8i; qi = qr * a8i + qi * a8r; qr = t; }
    }
    for (int i = tid; i < 1024; i += 512) { CR[(i >> 6) * 65 + (i & 63)] = pCR[(size_t)lg * 1024 + i]; CI[(i >> 6) * 65 + (i & 63)] = pCI[(size_t)lg * 1024 + i]; }
    if (tid < 16) DD[tid] = pD[lg * 16 + tid];
    __syncthreads();
    for (int e = tid; e < 2048; e += 512) { const int d = e >> 8, i = (e >> 4) & 15, j = e & 15; float s = 0.f;
        for (int p = 0; p < 64; ++p) { const float pr = PWr[d * 64 + p], pi = PWi[d * 64 + p], br = BBr[p * 16 + j], bi = BBi[p * 16 + j];
            const float zr = pr * br - pi * bi, zi = pr * bi + pi * br; s += CR[i * 65 + p] * zr - CI[i * 65 + p] * zi; }
        KT[e] = s; }
    __syncthreads();
    bf16* KM = (bf16*)mb; bf16* G8 = (bf16*)(mb + 32768); bf16* E8 = (bf16*)(mb + 65536);
    for (int q = tid; q < 2048; q += 512) { const int n = q >> 4, k0 = (q & 15) * 8;
        float v[8];
        { const int t = n >> 4, i = n & 15, s = k0 >> 4, j0 = k0 & 15;
#pragma unroll
          for (int e = 0; e < 8; ++e) { const int j = j0 + e; v[e] = (s <= t) ? (KT[((t - s) * 16 + i) * 16 + j] + ((s == t && i == j) ? DD[i] : 0.f)) : 0.f; }
          v4u o; o.x = pk2(v[0], v[1]); o.y = pk2(v[2], v[3]); o.z = pk2(v[4], v[5]); o.w = pk2(v[6], v[7]); *(v4u*)(KM + n * 128 + k0) = o; }
        { const int pb = n >> 5, ri = (n >> 4) & 1, p = 16 * pb + (n & 15), s = k0 >> 4, j0 = k0 & 15; const float pr = PWr[(7 - s) * 64 + p], pi = PWi[(7 - s) * 64 + p];
#pragma unroll
          for (int e = 0; e < 8; ++e) { const float br = BBr[p * 16 + j0 + e], bi = BBi[p * 16 + j0 + e]; v[e] = ri ? (pr * bi + pi * br) : (pr * br - pi * bi); }
          v4u o; o.x = pk2(v[0], v[1]); o.y = pk2(v[2], v[3]); o.z = pk2(v[4], v[5]); o.w = pk2(v[6], v[7]); *(v4u*)(G8 + n * 128 + k0) = o; }
        { const int t = n >> 4, i = n & 15, pb = k0 >> 5, ri = (k0 >> 4) & 1, p0 = 16 * pb + (k0 & 15);
#pragma unroll
          for (int e = 0; e < 8; ++e) { const int p = p0 + e; const float ar = PWr[(t + 1) * 64 + p], ai = PWi[(t + 1) * 64 + p], cr = CR[i * 65 + p], ci = CI[i * 65 + p];
              v[e] = ri ? -(cr * ai + ci * ar) : (cr * ar - ci * ai); }
          v4u o; o.x = pk2(v[0], v[1]); o.y = pk2(v[2], v[3]); o.z = pk2(v[4], v[5]); o.w = pk2(v[6], v[7]); *(v4u*)(E8 + n * 128 + k0) = o; }
    }
    __syncthreads();
}

template <bool XBF_P, bool XBF_S>
__device__ __forceinline__ void norm_phase(const Frame& F, const void* xp, const void* xs, int mode, int lm, const bf16* part, const float* gate, bf16* xdst, int npl) {
    const int lane = F.lane, wv = F.wave, cwg = (int)blockIdx.x; const int nph = 8 - npl, nrows = wv < 4 ? npl + 1 : nph;
    const float* MOD = (const float*)(F.ws + WS_MOD); bf16* H = (bf16*)(F.ws + WS_HP);
    LAS float* LM = (LAS float*)F.lds; LAS float* LS = LM + DM;
    if (mode == 0) { const int seqp = (32 * cwg) >> 11; const float* md = MOD + (size_t)(lm * NSEQ + seqp) * MODW + 8 * F.tid; const float* gn = inptr(F, I_GN) + (size_t)lm * DM + 8 * F.tid;
        const f32x4 g0 = *(const f32x4*)gn, g1 = *(const f32x4*)(gn + 4), sc0 = *(const f32x4*)(md + DM), sc1 = *(const f32x4*)(md + DM + 4), sh0 = *(const f32x4*)md, sh1 = *(const f32x4*)(md + 4);
        *(LAS f32x4*)(LM + 8 * F.tid) = g0 * (sc0 + 1.0f); *(LAS f32x4*)(LM + 8 * F.tid + 4) = g1 * (sc1 + 1.0f); *(LAS f32x4*)(LS + 8 * F.tid) = sh0; *(LAS f32x4*)(LS + 8 * F.tid + 4) = sh1;
        __syncthreads(); }
    auto rowof = [&](int k) -> int { return wv < 4 ? (k == 0 ? NPROMPT + 4 * cwg + wv : 32 * cwg + wv * npl + (k - 1)) : 32 * cwg + 4 * npl + (wv - 4) * nph + k; };
    auto finish_rows = [&](int r0, int r1, bool has1, const f32x4 (&va)[16], const f32x4 (&vb)[16], float sa, float sb, bool from_lds) {
        sa = wave_sum(sa); const float rs0 = 1.0f / sqrtf(sa * (1.0f / DM) + RMS_EPS); float rs1 = 0.f; if (has1) { sb = wave_sum(sb); rs1 = 1.0f / sqrtf(sb * (1.0f / DM) + RMS_EPS); }
        if (mode == 0 && from_lds) {
#pragma unroll
            for (int j = 0; j < 8; ++j) { const int col = 8 * (lane + 64 * j);
                const f32x4 m0 = *(const LAS f32x4*)(LM + col), m1 = *(const LAS f32x4*)(LM + col + 4), s0 = *(const LAS f32x4*)(LS + col), s1 = *(const LAS f32x4*)(LS + col + 4);
                { const f32x4 o0 = va[2 * j] * rs0 * m0 + s0, o1 = va[2 * j + 1] * rs0 * m1 + s1;
                  v4u w; w.x = pk2(o0.x, o0.y); w.y = pk2(o0.z, o0.w); w.z = pk2(o1.x, o1.y); w.w = pk2(o1.z, o1.w); *(v4u*)(H + (size_t)r0 * LDK + col) = w; }
                if (has1) { const f32x4 o0 = vb[2 * j] * rs1 * m0 + s0, o1 = vb[2 * j + 1] * rs1 * m1 + s1;
                  v4u w; w.x = pk2(o0.x, o0.y); w.y = pk2(o0.z, o0.w); w.z = pk2(o1.x, o1.y); w.w = pk2(o1.z, o1.w); *(v4u*)(H + (size_t)r1 * LDK + col) = w; } }
        } else if (mode == 0) {
            const float* md = MOD + (size_t)(lm * NSEQ + seq_of_row(r0)) * MODW + 8 * lane; const float* gn = inptr(F, I_GN) + (size_t)lm * DM + 8 * lane;
#pragma unroll
            for (int jg = 0; jg < 4; ++jg) { f32x4 g_[2][2], sc_[2][2], sh_[2][2];
#pragma unroll
                for (int u = 0; u < 2; ++u) { const int o = 512 * (2 * jg + u); g_[u][0] = *(const f32x4*)(gn + o); g_[u][1] = *(const f32x4*)(gn + o + 4);
                    sc_[u][0] = *(const f32x4*)(md + DM + o); sc_[u][1] = *(const f32x4*)(md + DM + o + 4); sh_[u][0] = *(const f32x4*)(md + o); sh_[u][1] = *(const f32x4*)(md + o + 4); }
                __builtin_amdgcn_sched_barrier(0);
#pragma unroll
                for (int u = 0; u < 2; ++u) { const int j = 2 * jg + u, col = 8 * (lane + 64 * j);
                    const f32x4 m0 = g_[u][0] * (sc_[u][0] + 1.0f), m1 = g_[u][1] * (sc_[u][1] + 1.0f);
                    { const f32x4 o0 = va[2 * j] * rs0 * m0 + sh_[u][0], o1 = va[2 * j + 1] * rs0 * m1 + sh_[u][1];
                      v4u w; w.x = pk2(o0.x, o0.y); w.y = pk2(o0.z, o0.w); w.z = pk2(o1.x, o1.y); w.w = pk2(o1.z, o1.w); *(v4u*)(H + (size_t)r0 * LDK + col) = w; }
                    if (has1) { const f32x4 o0 = vb[2 * j] * rs1 * m0 + sh_[u][0], o1 = vb[2 * j + 1] * rs1 * m1 + sh_[u][1];
                      v4u w; w.x = pk2(o0.x, o0.y); w.y = pk2(o0.z, o0.w); w.z = pk2(o1.x, o1.y); w.w = pk2(o1.z, o1.w); *(v4u*)(H + (size_t)r1 * LDK + col) = w; } } }
        } else {
            const float* gn = inptr(F, I_GFIN) + 8 * lane; float* or0 = F.out + O_Y + (size_t)r0 * DM + 8 * lane; float* or1 = F.out + O_Y + (size_t)r1 * DM + 8 * lane;
            f32x4 g_[8][2];
#pragma unroll
            for (int j = 0; j < 8; ++j) { g_[j][0] = *(const f32x4*)(gn + 512 * j); g_[j][1] = *(const f32x4*)(gn + 512 * j + 4); }
            __builtin_amdgcn_sched_barrier(0);
#pragma unroll
            for (int j = 0; j < 8; ++j) { *(f32x4*)(or0 + 512 * j) = va[2 * j] * rs0 * g_[j][0]; *(f32x4*)(or0 + 512 * j + 4) = va[2 * j + 1] * rs0 * g_[j][1];
                if (has1) { *(f32x4*)(or1 + 512 * j) = vb[2 * j] * rs1 * g_[j][0]; *(f32x4*)(or1 + 512 * j + 4) = vb[2 * j + 1] * rs1 * g_[j][1]; } }
        }
    };
    auto finish_row = [&](int row, const f32x4 (&v)[16], float ss) { finish_rows(row, row, false, v, v, ss, 0.f, false); };
#define NORM_SS(a, b) (((a.x * a.x + a.y * a.y) + (a.z * a.z + a.w * a.w)) + ((b.x * b.x + b.y * b.y) + (b.z * b.z + b.w * b.w)))
    auto row_f32 = [&](int row, const float* base) { const float* xr = base + (size_t)(row >= NPROMPT ? row - NPROMPT : row) * DM + 8 * lane;
        f32x4 v[16]; float ss = 0.f;
#pragma unroll
        for (int j = 0; j < 8; ++j) { v[2 * j] = *(const f32x4*)(xr + 512 * j); v[2 * j + 1] = *(const f32x4*)(xr + 512 * j + 4); }
        __builtin_amdgcn_sched_barrier(0);
#pragma unroll
        for (int j = 0; j < 8; ++j) ss += NORM_SS(v[2 * j], v[2 * j + 1]);
        finish_row(row, v, ss); };
    auto rows_f32 = [&](int r0, int r1, bool has1, const float* base) { const float* x0 = base + (size_t)r0 * DM + 8 * lane; const float* x1 = base + (size_t)r1 * DM + 8 * lane;
        f32x4 va[16], vb[16]; float sa = 0.f, sb = 0.f;
#pragma unroll
        for (int j = 0; j < 8; ++j) { va[2 * j] = *(const f32x4*)(x0 + 512 * j); va[2 * j + 1] = *(const f32x4*)(x0 + 512 * j + 4); }
#pragma unroll
        for (int j = 0; j < 8; ++j) { vb[2 * j] = *(const f32x4*)(x1 + 512 * j); vb[2 * j + 1] = *(const f32x4*)(x1 + 512 * j + 4); }
        __builtin_amdgcn_sched_barrier(0);
#pragma unroll
        for (int j = 0; j < 8; ++j) { sa += NORM_SS(va[2 * j], va[2 * j + 1]); sb += NORM_SS(vb[2 * j], vb[2 * j + 1]); }
        finish_rows(r0, r1, has1, va, vb, sa, sb, true); };
    auto rows_bf16 = [&](int r0, int r1, bool has1) { const bf16* p0 = (const bf16*)xp + (size_t)r0 * DM + 8 * lane; const bf16* p1 = (const bf16*)xp + (size_t)r1 * DM + 8 * lane;
        v4u ta[8], tb[8];
#pragma unroll
        for (int j = 0; j < 8; ++j) ta[j] = *(const v4u*)(p0 + 512 * j);
#pragma unroll
        for (int j = 0; j < 8; ++j) tb[j] = *(const v4u*)(p1 + 512 * j);
        __builtin_amdgcn_sched_barrier(0);
        f32x4 va[16], vb[16]; float sa = 0.f, sb = 0.f;
#pragma unroll
        for (int j = 0; j < 8; ++j) { const v4u t = ta[j]; va[2 * j] = (f32x4){bflo(t.x), bfhi(t.x), bflo(t.y), bfhi(t.y)}; va[2 * j + 1] = (f32x4){bflo(t.z), bfhi(t.z), bflo(t.w), bfhi(t.w)}; sa += NORM_SS(va[2 * j], va[2 * j + 1]); }
#pragma unroll
        for (int j = 0; j < 8; ++j) { const v4u t = tb[j]; vb[2 * j] = (f32x4){bflo(t.x), bfhi(t.x), bflo(t.y), bfhi(t.y)}; vb[2 * j + 1] = (f32x4){bflo(t.z), bfhi(t.z), bflo(t.w), bfhi(t.w)}; sb += NORM_SS(vb[2 * j], vb[2 * j + 1]); }
        finish_rows(r0, r1, has1, va, vb, sa, sb, true); };
    auto row_sample = [&](int row) { const size_t ro = (size_t)(row - NPROMPT) * DM; const float* gr0 = gate + (size_t)seq_of_row(row) * MODW;
        f32x4 v[16]; float ss = 0.f;
#pragma unroll
        for (int jg = 0; jg < 4; ++jg) { f32x4 xa[2], xb[2], ga[2], gb[2]; v4u xt[2], q0[2], q1[2], q2[2], q3[2];
#pragma unroll
            for (int u = 0; u < 2; ++u) { const int col = 8 * (lane + 64 * (2 * jg + u)); const bf16* pp = part + ro + col;
                if (XBF_S) xt[u] = *(const v4u*)((const bf16*)xs + ro + col); else { const float* xr = (const float*)xs + ro + col; xa[u] = *(const f32x4*)xr; xb[u] = *(const f32x4*)(xr + 4); }
                q0[u] = *(const v4u*)pp; q1[u] = *(const v4u*)(pp + (size_t)1024 * DM); q2[u] = *(const v4u*)(pp + (size_t)2048 * DM); q3[u] = *(const v4u*)(pp + (size_t)3072 * DM);
                ga[u] = *(const f32x4*)(gr0 + col); gb[u] = *(const f32x4*)(gr0 + col + 4); }
            __builtin_amdgcn_sched_barrier(0);
#pragma unroll
            for (int u = 0; u < 2; ++u) { const int j = 2 * jg + u, col = 8 * (lane + 64 * j); f32x4 a, b;
                if (XBF_S) { const v4u t = xt[u]; a = (f32x4){bflo(t.x), bfhi(t.x), bflo(t.y), bfhi(t.y)}; b = (f32x4){bflo(t.z), bfhi(t.z), bflo(t.w), bfhi(t.w)}; } else { a = xa[u]; b = xb[u]; }
                const f32x4 pa = ((f32x4){bflo(q0[u].x), bfhi(q0[u].x), bflo(q0[u].y), bfhi(q0[u].y)} + (f32x4){bflo(q1[u].x), bfhi(q1[u].x), bflo(q1[u].y), bfhi(q1[u].y)}) + ((f32x4){bflo(q2[u].x), bfhi(q2[u].x), bflo(q2[u].y), bfhi(q2[u].y)} + (f32x4){bflo(q3[u].x), bfhi(q3[u].x), bflo(q3[u].y), bfhi(q3[u].y)});
                const f32x4 pb = ((f32x4){bflo(q0[u].z), bfhi(q0[u].z), bflo(q0[u].w), bfhi(q0[u].w)} + (f32x4){bflo(q1[u].z), bfhi(q1[u].z), bflo(q1[u].w), bfhi(q1[u].w)}) + ((f32x4){bflo(q2[u].z), bfhi(q2[u].z), bflo(q2[u].w), bfhi(q2[u].w)} + (f32x4){bflo(q3[u].z), bfhi(q3[u].z), bflo(q3[u].w), bfhi(q3[u].w)});
                a = a + ga[u] * pa; b = b + gb[u] * pb;
                if (xdst) { v4u w; w.x = pk2(a.x, a.y); w.y = pk2(a.z, a.w); w.z = pk2(b.x, b.y); w.w = pk2(b.z, b.w); *(v4u*)(xdst + ro + col) = w; }
                v[2 * j] = a; v[2 * j + 1] = b; ss += NORM_SS(a, b); } }
        finish_row(row, v, ss); };
    int k = 0;
    if (wv < 4) { const int row = rowof(0); k = 1;
        if (part != nullptr) row_sample(row); else row_f32(row, (const float*)xs); }
    if (XBF_P) { for (; k < nrows; k += 2) { const bool has1 = k + 1 < nrows; rows_bf16(rowof(k), rowof(has1 ? k + 1 : k), has1); } }
    else { for (; k < nrows; k += 2) { const bool has1 = k + 1 < nrows; rows_f32(rowof(k), rowof(has1 ? k + 1 : k), has1, (const float*)xp); } }
#undef NORM_SS
}

constexpr int OFF_CIN = 0, OFF_PG = 1024;
struct EpiProj {
    static constexpr bool PERM = true, AFTER_DRAIN = false;
    bf16* O;
    __device__ __forceinline__ void operator()(const f32x4 (&acc)[2][2][4][2], const pg8::Unit& u, int wr, int wc, int fr, int fq) const {
        const int row0 = u.pm * 256 + wr * 64 + fr;
        if (u.pn < 16) { const int ch = 64 * u.pn + 32 * (wc & 1) + 8 * fq; const bool gatep = wc >= 2;
#pragma unroll
            for (int ai = 0; ai < 2; ++ai)
#pragma unroll
                for (int m = 0; m < 4; ++m) { bf16* rowp = O + (size_t)(row0 + ai * 128 + m * 16) * INC + (gatep ? OFF_PG : OFF_CIN) + ch;
                    const f32x4 p0 = acc[ai][0][m][0], p1 = acc[ai][0][m][1], q0 = acc[ai][1][m][0], q1 = acc[ai][1][m][1]; f32x4 r0, r1;
                    if (gatep) { r0 = (f32x4){p0[0] * silu(q0[0]), p0[1] * silu(q0[1]), p0[2] * silu(q0[2]), p0[3] * silu(q0[3])}; r1 = (f32x4){p1[0] * silu(q1[0]), p1[1] * silu(q1[1]), p1[2] * silu(q1[2]), p1[3] * silu(q1[3])}; }
                    else { r0 = p0 * q0; r1 = p1 * q1; }
                    v4u w; w.x = pg8::cvt_pk_bf16(r0[0], r0[1]); w.y = pg8::cvt_pk_bf16(r0[2], r0[3]); w.z = pg8::cvt_pk_bf16(r1[0], r1[1]); w.w = pg8::cvt_pk_bf16(r1[2], r1[3]);
                    *(v4u*)rowp = w; }
            return; }
        const int col0 = u.pn * 256 + wc * 32 + 8 * fq;
#pragma unroll
        for (int ai = 0; ai < 2; ++ai)
#pragma unroll
            for (int m = 0; m < 4; ++m) { bf16* rowp = O + (size_t)(row0 + ai * 128 + m * 16) * INC + col0;
#pragma unroll
                for (int bj = 0; bj < 2; ++bj) { const f32x4 v0 = acc[ai][bj][m][0], v1 = acc[ai][bj][m][1];
                    v4u w; w.x = pg8::cvt_pk_bf16(v0[0], v0[1]); w.y = pg8::cvt_pk_bf16(v0[2], v0[3]); w.z = pg8::cvt_pk_bf16(v1[0], v1[1]); w.w = pg8::cvt_pk_bf16(v1[2], v1[3]);
                    *(v4u*)(rowp + bj * 128) = w; } }
    }
};
template <bool XBF> struct EpiResGate {
    static constexpr bool PERM = true, AFTER_DRAIN = false;
    const void* xp; const void* xs; bf16* out; const float* gate;
    bf16* part;
    __device__ __forceinline__ void operator()(const f32x4 (&acc)[2][2][4][2], const pg8::Unit& u, int wr, int wc, int fr, int fq) const {
        const int row0 = u.pm * 256 + wr * 64 + fr, col0 = u.pn * 256 + wc * 32 + 8 * fq;
        if (u.nkt != 64) { bf16* pb = part + (size_t)(u.kt0 >> 4) * 1024 * DM;
#pragma unroll
            for (int ai = 0; ai < 2; ++ai)
#pragma unroll
                for (int m = 0; m < 4; ++m) { bf16* orow = pb + (size_t)(row0 + ai * 128 + m * 16 - NPROMPT) * DM + col0;
#pragma unroll
                    for (int bj = 0; bj < 2; ++bj) { const f32x4 a0 = acc[ai][bj][m][0], a1 = acc[ai][bj][m][1]; v4u w; w.x = pk2(a0[0], a0[1]); w.y = pk2(a0[2], a0[3]); w.z = pk2(a1[0], a1[1]); w.w = pk2(a1[2], a1[3]);
                        *(v4u*)(orow + bj * 128) = w; } }
            return; }
        const bool uni = u.pm < 32;
        f32x4 g0[2], g1[2];
        { const float* gr = gate + (size_t)(uni ? (u.pm >> 3) : 0) * MODW + col0;
#pragma unroll
          for (int bj = 0; bj < 2; ++bj) { g0[bj] = *(const f32x4*)(gr + bj * 128); g1[bj] = *(const f32x4*)(gr + bj * 128 + 4); } }
#pragma unroll
        for (int ai = 0; ai < 2; ++ai)
#pragma unroll
            for (int m = 0; m < 4; ++m) { const int row = row0 + ai * 128 + m * 16; const bool smp = row >= NPROMPT; const size_t ro = (smp ? (size_t)(row - NPROMPT) : (size_t)row) * DM + col0;
                if (!uni) { const float* gr = gate + (size_t)seq_of_row(row) * MODW + col0;
#pragma unroll
                    for (int bj = 0; bj < 2; ++bj) { g0[bj] = *(const f32x4*)(gr + bj * 128); g1[bj] = *(const f32x4*)(gr + bj * 128 + 4); } }
#pragma unroll
                for (int bj = 0; bj < 2; ++bj) { f32x4 x0, x1;
                    if (XBF) { const v4u t = *(const v4u*)((const bf16*)(smp ? xs : xp) + ro + bj * 128); x0 = (f32x4){bflo(t.x), bfhi(t.x), bflo(t.y), bfhi(t.y)}; x1 = (f32x4){bflo(t.z), bfhi(t.z), bflo(t.w), bfhi(t.w)}; }
                    else { const float* xr = (const float*)(smp ? xs : xp) + ro + bj * 128; x0 = *(const f32x4*)xr; x1 = *(const f32x4*)(xr + 4); }
                    const f32x4 o0 = x0 + g0[bj] * acc[ai][bj][m][0], o1 = x1 + g1[bj] * acc[ai][bj][m][1];
                    v4u w; w.x = pk2(o0[0], o0[1]); w.y = pk2(o0[2], o0[3]); w.z = pk2(o1[0], o1[1]); w.w = pk2(o1[2], o1[3]);
                    *(v4u*)(out + (size_t)row * DM + col0 + bj * 128) = w; }
                asm volatile("" ::: "memory"); }
    }
};
struct Gemm2Order {
    pg8::StaticOrder so; int c; bool split;
    __device__ __forceinline__ void init(int G, int c_) { split = true; c = c_; so.init(NPROMPT, DM, G, c_, DM); }
    __device__ __forceinline__ bool next(int i, pg8::Unit& u) const {
        if (!split || i < 2) return so.next(i, u);
        if (i == 2) { const int x = c & 7, j = c >> 3; u.pm = 32 + (j & 3); u.pn = 8 * (x >> 2) + (j >> 2); u.kt0 = 16 * (x & 3); u.nkt = 16; return true; }
        return false;
    }
    __device__ __forceinline__ void a_ready(const pg8::Unit&) const {}
    __device__ __forceinline__ void done(const pg8::Unit&) const {}
};
struct EpiGlu {
    static constexpr bool PERM = true, AFTER_DRAIN = false;
    const bf16* YG; const bf16* PROJ; const float* bglu; bf16* MIX;
    __device__ __forceinline__ void operator()(const f32x4 (&acc)[2][2][4][2], const pg8::Unit& u, int wr, int wc, int fr, int fq) const {
        const int row0 = u.pm * 256 + wr * 64 + fr, col0 = u.pn * 256 + wc * 32 + 8 * fq;
#pragma unroll
        for (int bj = 0; bj < 2; ++bj) { const int col = col0 + bj * 128; const f32x4 b0 = *(const f32x4*)(bglu + col), b1 = *(const f32x4*)(bglu + col + 4);
#pragma unroll
            for (int ai = 0; ai < 2; ++ai)
#pragma unroll
                for (int m = 0; m < 4; ++m) { const int row = row0 + ai * 128 + m * 16;
                    const v4u yv = *(const v4u*)(YG + (size_t)row * 1024 + col), cv = *(const v4u*)(PROJ + (size_t)row * INC + OFF_CG + col);
                    float y[8], c[8]; UNPK8(yv, y); UNPK8(cv, c);
                    const f32x4 z0 = acc[ai][bj][m][0] + b0, z1 = acc[ai][bj][m][1] + b1; float o[8];
#pragma unroll
                    for (int e = 0; e < 4; ++e) { o[e] = y[e] * sigm(z0[e]) * silu(c[e]); o[4 + e] = y[4 + e] * sigm(z1[e]) * silu(c[4 + e]); }
                    v4u w; w.x = pg8::cvt_pk_bf16(o[0], o[1]); w.y = pg8::cvt_pk_bf16(o[2], o[3]); w.z = pg8::cvt_pk_bf16(o[4], o[5]); w.w = pg8::cvt_pk_bf16(o[6], o[7]);
                    *(v4u*)(MIX + (size_t)row * DM + 3072 + col) = w; } }
    }
};

__device__ __forceinline__ void s5_phase_roles(const Frame& F, int l) {
    const int wg = blockIdx.x; if (wg >= 256) return;
    const int g = wg & 63, pbq = wg >> 6; const int lane = F.lane, w = F.wave, fr = lane & 15, fq = lane >> 4;
    const unsigned char* mb = F.ws + WS_S5M + (size_t)(l * 64 + g) * S5M_STRIDE;
    const bf16* KM = (const bf16*)mb; const bf16* G8 = (const bf16*)(mb + 32768); const bf16* E8 = (const bf16*)(mb + 65536); const float* A8P = (const float*)(mb + 98304);
    const bf16* PROJ = (const bf16*)(F.ws + WS_PROJ); bf16* YG = (bf16*)(F.ws + WS_YG);
    LAS bf16* HT = (LAS bf16*)F.lds;
    LAS bf16* YS = HT + 2 * 16 * 136;
    LAS bf16* US = YS + 2 * 2048;
    const int urow = F.tid >> 2, uq = F.tid & 3;
    u32x2 P0, P1, P2, P3, P4, P5;
#define S5_ROW0(it_) ((it_) >= 16 ? NPROMPT + 128 * (pbq + 4 * ((it_) - 16)) : pbq * 2048 + 128 * (it_))
#define S5_UFETCH(it_) (*(const u32x2*)(PROJ + (size_t)(S5_ROW0(it_) + urow) * INC + OFF_CU + 16 * g + 4 * uq))
#define S5_UPUT(buf_, v_) (*(LAS u32x2*)(US + (buf_) * 2048 + (((urow & 7) * 16 + (urow >> 3)) * 16) + 4 * uq) = (v_))
#define S5_UFRAG(U_, buf_) do { _Pragma("unroll") for (int kk = 0; kk < 4; ++kk) U_[kk] = *(const LAS bf16x8*)(US + (buf_) * 2048 + (((2 * kk + (fq >> 1)) * 16 + fr) * 16) + 8 * (fq & 1)); } while (0)
#define S5_NEXT(PN_, i_, K_) do { S5_UPUT(((K_) + 1) % 3, PN_); { const int itn = (i_) + 7 < 18 ? (i_) + 7 : 17; PN_ = S5_UFETCH(itn); } } while (0)
    P0 = S5_UFETCH(0); P1 = S5_UFETCH(1); P2 = S5_UFETCH(2); P3 = S5_UFETCH(3); P4 = S5_UFETCH(4); P5 = S5_UFETCH(5);
    S5_UPUT(0, P0); P0 = S5_UFETCH(6);
    if (w < 4) {
        bf16x8 BG0[4], BG1[4];
#pragma unroll
        for (int kk = 0; kk < 4; ++kk) { BG0[kk] = *(const bf16x8*)(G8 + (16 * (2 * w) + fr) * 128 + 32 * kk + 8 * fq); BG1[kk] = *(const bf16x8*)(G8 + (16 * (2 * w + 1) + fr) * 128 + 32 * kk + 8 * fq); }
        const int p = 16 * w + fr;
        const float a1r = A8P[p], a1i = A8P[64 + p], a2r = A8P[128 + p], a2i = A8P[192 + p], a3r = A8P[256 + p], a3i = A8P[320 + p], a4r = A8P[384 + p], a4i = A8P[448 + p];
        float cr_ = 0.f, ci_ = 0.f;
        __syncthreads();
#define S5_CHAIN(PN_, ix, K_) do { const int it = (ix); const bool smp = it >= 16; \
        LAS bf16* hb = HT + ((K_) & 1) * 16 * 136; \
        bf16x8 U_[4]; S5_UFRAG(U_, (K_) % 3); \
        f32x4 S0 = (f32x4){0.f, 0.f, 0.f, 0.f}, S1 = (f32x4){0.f, 0.f, 0.f, 0.f}; \
        _Pragma("unroll") \
        for (int kk = 0; kk < 4; ++kk) { S0 = __builtin_amdgcn_mfma_f32_16x16x32_bf16(U_[kk], BG0[kk], S0, 0, 0, 0); S1 = __builtin_amdgcn_mfma_f32_16x16x32_bf16(U_[kk], BG1[kk], S1, 0, 0, 0); } \
        S5_NEXT(PN_, it, K_); \
        float hr[4], hi[4]; \
        if (!smp) { \
            float Lr[4], Li[4]; Lr[0] = S0[0]; Li[0] = S1[0]; \
        _Pragma("unroll") \
            for (int r = 1; r < 4; ++r) { Lr[r] = a1r * Lr[r - 1] - a1i * Li[r - 1] + S0[r]; Li[r] = a1r * Li[r - 1] + a1i * Lr[r - 1] + S1[r]; } \
            float tr = cr_, ti = ci_, br = cr_, bi = ci_; \
        _Pragma("unroll") \
            for (int q = 0; q < 4; ++q) { const float er = __shfl(Lr[3], fr + 16 * q), ei = __shfl(Li[3], fr + 16 * q); \
                const float ntr = a4r * tr - a4i * ti + er, nti = a4r * ti + a4i * tr + ei; tr = ntr; ti = nti; if (fq == q + 1) { br = tr; bi = ti; } } \
            cr_ = tr; ci_ = ti; \
            hr[0] = br; hi[0] = bi; \
            hr[1] = a1r * br - a1i * bi + Lr[0]; hi[1] = a1r * bi + a1i * br + Li[0]; \
            hr[2] = a2r * br - a2i * bi + Lr[1]; hi[2] = a2r * bi + a2i * br + Li[1]; \
            hr[3] = a3r * br - a3i * bi + Lr[2]; hi[3] = a3r * bi + a3i * br + Li[2]; \
        } else { \
        _Pragma("unroll") \
            for (int r = 0; r < 4; ++r) { const int b = 16 * (pbq + 4 * (it - 16)) + 4 * fq + r; const size_t si = (size_t)((l * 128 + b) * 64 + g) * 64 + p; \
                hr[r] = inptr(F, I_SRE)[si]; hi[r] = inptr(F, I_SIM)[si]; \
                F.out[O_SRE + si] = a1r * hr[r] - a1i * hi[r] + S0[r]; F.out[O_SIM + si] = a1r * hi[r] + a1i * hr[r] + S1[r]; } \
        } \
        _Pragma("unroll") \
        for (int r = 0; r < 4; ++r) { hb[(4 * fq + r) * 136 + 32 * w + fr] = (bf16)f2bf(hr[r]); hb[(4 * fq + r) * 136 + 32 * w + 16 + fr] = (bf16)f2bf(hi[r]); } \
        __syncthreads(); \
    } while (0)
        for (int i6 = 0; i6 < 18; i6 += 6) { S5_CHAIN(P1, i6, 0); S5_CHAIN(P2, i6 + 1, 1); S5_CHAIN(P3, i6 + 2, 2); S5_CHAIN(P4, i6 + 3, 3); S5_CHAIN(P5, i6 + 4, 4); S5_CHAIN(P0, i6 + 5, 5); }
#undef S5_CHAIN
        if (fq == 0) { const size_t si = (size_t)((l * 4 + pbq) * 64 + g) * 64 + p; F.out[O_PRE + si] = cr_; F.out[O_PIM + si] = ci_; }
        __syncthreads();
    } else {
        const int t0 = 2 * (w - 4), x = F.tid - 256;
        bf16x8 BK0[4], BK1[4], BE0[4], BE1[4];
#pragma unroll
        for (int kk = 0; kk < 4; ++kk) { BK0[kk] = *(const bf16x8*)(KM + (16 * t0 + fr) * 128 + 32 * kk + 8 * fq); BK1[kk] = *(const bf16x8*)(KM + (16 * (t0 + 1) + fr) * 128 + 32 * kk + 8 * fq);
            BE0[kk] = *(const bf16x8*)(E8 + (16 * t0 + fr) * 128 + 32 * kk + 8 * fq); BE1[kk] = *(const bf16x8*)(E8 + (16 * (t0 + 1) + fr) * 128 + 32 * kk + 8 * fq); }
        __syncthreads();
        S5_NEXT(P1, 0, 0); __syncthreads();
#define S5_OUT(PN_, ix, K_) do { const int i = (ix), j = i - 1; const LAS bf16* hb = HT + (((K_) + 1) & 1) * 16 * 136;     \
        if (j > 0) { const int rp_ = S5_ROW0(j - 1) + (x >> 1);     \
            *(v4u*)(YG + (size_t)rp_ * 1024 + 16 * g + 8 * (x & 1)) = *(const LAS v4u*)(YS + ((K_) & 1) * 2048 + (x >> 1) * 16 + 8 * (x & 1)); } \
        bf16x8 U_[4]; S5_UFRAG(U_, ((K_) + 2) % 3); \
        f32x4 Y0 = (f32x4){0.f, 0.f, 0.f, 0.f}, Y1 = (f32x4){0.f, 0.f, 0.f, 0.f}; \
        _Pragma("unroll") \
        for (int kk = 0; kk < 4; ++kk) { Y0 = __builtin_amdgcn_mfma_f32_16x16x32_bf16(U_[kk], BK0[kk], Y0, 0, 0, 0); Y1 = __builtin_amdgcn_mfma_f32_16x16x32_bf16(U_[kk], BK1[kk], Y1, 0, 0, 0); } \
        if (i < 18) S5_NEXT(PN_, i, K_); \
        _Pragma("unroll") \
        for (int kk = 0; kk < 4; ++kk) { const bf16x8 HA = *(const LAS bf16x8*)(hb + fr * 136 + 32 * kk + 8 * fq); \
            Y0 = __builtin_amdgcn_mfma_f32_16x16x32_bf16(HA, BE0[kk], Y0, 0, 0, 0); Y1 = __builtin_amdgcn_mfma_f32_16x16x32_bf16(HA, BE1[kk], Y1, 0, 0, 0); } \
        _Pragma("unroll") \
        for (int r = 0; r < 4; ++r) { YS[(((K_) + 1) & 1) * 2048 + (8 * (4 * fq + r) + t0) * 16 + fr] = (bf16)f2bf(gelu_tanh(Y0[r])); YS[(((K_) + 1) & 1) * 2048 + (8 * (4 * fq + r) + t0 + 1) * 16 + fr] = (bf16)f2bf(gelu_tanh(Y1[r])); } \
        __syncthreads(); \
    } while (0)
        S5_OUT(P2, 1, 1); S5_OUT(P3, 2, 2); S5_OUT(P4, 3, 3); S5_OUT(P5, 4, 4); S5_OUT(P0, 5, 5);
        for (int i6 = 6; i6 < 18; i6 += 6) { S5_OUT(P1, i6, 0); S5_OUT(P2, i6 + 1, 1); S5_OUT(P3, i6 + 2, 2); S5_OUT(P4, i6 + 3, 3); S5_OUT(P5, i6 + 4, 4); S5_OUT(P0, i6 + 5, 5); }
        S5_OUT(P1, 18, 0);
#undef S5_OUT
        { const int rp_ = S5_ROW0(17) + (x >> 1); *(v4u*)(YG + (size_t)rp_ * 1024 + 16 * g + 8 * (x & 1)) = *(const LAS v4u*)(YS + 2048 + (x >> 1) * 16 + 8 * (x & 1)); }
    }
#undef S5_NEXT
#undef S5_UFRAG
#undef S5_UPUT
#undef S5_UFETCH
#undef S5_ROW0
    __syncthreads();
}
template <int SV> __device__ __forceinline__ void s5_phase_t(const Frame& F, int l) {
    const int wg = blockIdx.x; if (wg >= 256) return;
    const int g = wg & 63, pbq = wg >> 6; const int lane = F.lane, w = F.wave, fr = lane & 15, fq = lane >> 4;
    const unsigned char* mb = F.ws + WS_S5M + (size_t)(l * 64 + g) * S5M_STRIDE;
    const bf16* KM = (const bf16*)mb; const bf16* G8 = (const bf16*)(mb + 32768); const bf16* E8 = (const bf16*)(mb + 65536); const float* A8P = (const float*)(mb + 98304);
    const bf16* PROJ = (const bf16*)(F.ws + WS_PROJ); bf16* YG = (bf16*)(F.ws + WS_YG);
    bf16x8 BK[4], BE[4], BG0[4], BG1[4];
#pragma unroll
    for (int kk = 0; kk < 4; ++kk) { BK[kk] = *(const bf16x8*)(KM + (16 * w + fr) * 128 + 32 * kk + 8 * fq); BE[kk] = *(const bf16x8*)(E8 + (16 * w + fr) * 128 + 32 * kk + 8 * fq); }
    const int wg2 = (w & 3);
#pragma unroll
    for (int kk = 0; kk < 4; ++kk) { BG0[kk] = *(const bf16x8*)(G8 + (16 * (2 * wg2) + fr) * 128 + 32 * kk + 8 * fq); BG1[kk] = *(const bf16x8*)(G8 + (16 * (2 * wg2 + 1) + fr) * 128 + 32 * kk + 8 * fq); }
    const int p = 16 * wg2 + fr;
    const float a1r = A8P[p], a1i = A8P[64 + p], a2r = A8P[128 + p], a2i = A8P[192 + p], a3r = A8P[256 + p], a3i = A8P[320 + p], a4r = A8P[384 + p], a4i = A8P[448 + p];
    float cr_ = 0.f, ci_ = 0.f;
    LAS bf16* HT = (LAS bf16*)F.lds;
    LAS bf16* YS = HT + 2 * 16 * 136;
    LAS bf16* US = YS + 2 * 2048;
    const int urow = F.tid >> 2, uq = F.tid & 3;
    u32x2 P0, P1, P2, P3, P4, P5;
#define S5_ROW0(it_) ((it_) >= 16 ? NPROMPT + 128 * (pbq + 4 * ((it_) - 16)) : pbq * 2048 + 128 * (it_))
#define S5_UFETCH(it_) (*(const u32x2*)(PROJ + (size_t)(S5_ROW0(it_) + urow) * INC + OFF_CU + 16 * g + 4 * uq))
#define S5_UPUT(buf_, v_) (*(LAS u32x2*)(US + (buf_) * 2048 + (((urow & 7) * 16 + (urow >> 3)) * 16) + 4 * uq) = (v_))
    P0 = S5_UFETCH(0); P1 = S5_UFETCH(1); P2 = S5_UFETCH(2); P3 = S5_UFETCH(3); P4 = S5_UFETCH(4); P5 = S5_UFETCH(5);
    S5_UPUT(0, P0); P0 = S5_UFETCH(6);
    __syncthreads();
#define S5_BODY(PN_, itx) do { const int it = (itx); const bool smp = it >= 16; const int row0 = S5_ROW0(it); \
        LAS bf16* hb = HT + (it & 1) * 16 * 136; \
        bf16x8 U_[4]; \
        _Pragma("unroll") for (int kk = 0; kk < 4; ++kk) U_[kk] = *(const LAS bf16x8*)(US + (it & 1) * 2048 + (((2 * kk + (fq >> 1)) * 16 + fr) * 16) + 8 * (fq & 1)); \
        f32x4 Y = (f32x4){0.f, 0.f, 0.f, 0.f}, S0 = (f32x4){0.f, 0.f, 0.f, 0.f}, S1 = (f32x4){0.f, 0.f, 0.f, 0.f}; \
        _Pragma("unroll") \
        for (int kk = 0; kk < 4; ++kk) { Y = __builtin_amdgcn_mfma_f32_16x16x32_bf16(U_[kk], BK[kk], Y, 0, 0, 0); S0 = __builtin_amdgcn_mfma_f32_16x16x32_bf16(U_[kk], BG0[kk], S0, 0, 0, 0); S1 = __builtin_amdgcn_mfma_f32_16x16x32_bf16(U_[kk], BG1[kk], S1, 0, 0, 0); } \
        asm volatile("" : "+v"(Y), "+v"(S0), "+v"(S1)); \
        S5_UPUT((it + 1) & 1, PN_); { const int itn = it + 7 < 18 ? it + 7 : 17; PN_ = S5_UFETCH(itn); } \
        if (w < 4 && !(SV & 1)) { \
            float hr[4], hi[4]; \
            if (!smp) { \
                float Lr[4], Li[4]; Lr[0] = S0[0]; Li[0] = S1[0]; \
        _Pragma("unroll") \
                for (int r = 1; r < 4; ++r) { Lr[r] = a1r * Lr[r - 1] - a1i * Li[r - 1] + S0[r]; Li[r] = a1r * Li[r - 1] + a1i * Lr[r - 1] + S1[r]; } \
                float tr = cr_, ti = ci_, br = cr_, bi = ci_; \
        _Pragma("unroll") \
                for (int q = 0; q < 4; ++q) { const float er = __shfl(Lr[3], fr + 16 * q), ei = __shfl(Li[3], fr + 16 * q); \
                    const float ntr = a4r * tr - a4i * ti + er, nti = a4r * ti + a4i * tr + ei; tr = ntr; ti = nti; if (fq == q + 1) { br = tr; bi = ti; } } \
                cr_ = tr; ci_ = ti; \
                hr[0] = br; hi[0] = bi; \
                hr[1] = a1r * br - a1i * bi + Lr[0]; hi[1] = a1r * bi + a1i * br + Li[0]; \
                hr[2] = a2r * br - a2i * bi + Lr[1]; hi[2] = a2r * bi + a2i * br + Li[1]; \
                hr[3] = a3r * br - a3i * bi + Lr[2]; hi[3] = a3r * bi + a3i * br + Li[2]; \
            } else { \
        _Pragma("unroll") \
                for (int r = 0; r < 4; ++r) { const int b = 16 * (pbq + 4 * (it - 16)) + 4 * fq + r; const size_t si = (size_t)((l * 128 + b) * 64 + g) * 64 + p; \
                    hr[r] = inptr(F, I_SRE)[si]; hi[r] = inptr(F, I_SIM)[si]; \
                    if (SV == 0) { F.out[O_SRE + si] = a1r * hr[r] - a1i * hi[r] + S0[r]; F.out[O_SIM + si] = a1r * hi[r] + a1i * hr[r] + S1[r]; } } \
            } \
        _Pragma("unroll") \
            for (int r = 0; r < 4; ++r) { hb[(4 * fq + r) * 136 + 32 * w + fr] = (bf16)f2bf(hr[r]); hb[(4 * fq + r) * 136 + 32 * w + 16 + fr] = (bf16)f2bf(hi[r]); } \
        } \
        __syncthreads(); \
        if (SV == 0 && it > 0 && F.tid < 256) { const int rp_ = S5_ROW0(it - 1) + (F.tid >> 1);     \
            *(v4u*)(YG + (size_t)rp_ * 1024 + 16 * g + 8 * (F.tid & 1)) = *(const LAS v4u*)(YS + ((it - 1) & 1) * 2048 + (F.tid >> 1) * 16 + 8 * (F.tid & 1)); } \
        if (!(SV & 2)) _Pragma("unroll") \
        for (int kk = 0; kk < 4; ++kk) { const bf16x8 HA = *(const LAS bf16x8*)(hb + fr * 136 + 32 * kk + 8 * fq); Y = __builtin_amdgcn_mfma_f32_16x16x32_bf16(HA, BE[kk], Y, 0, 0, 0); } \
        if (!(SV & 2)) _Pragma("unroll") \
        for (int r = 0; r < 4; ++r) YS[(it & 1) * 2048 + (8 * (4 * fq + r) + w) * 16 + fr] = (bf16)f2bf(gelu_tanh(Y[r])); \
    } while (0)
    for (int it6 = 0; it6 < 18; it6 += 6) { S5_BODY(P1, it6); S5_BODY(P2, it6 + 1); S5_BODY(P3, it6 + 2); S5_BODY(P4, it6 + 3); S5_BODY(P5, it6 + 4); S5_BODY(P0, it6 + 5); }
#undef S5_BODY
#undef S5_UFETCH
#undef S5_UPUT
    if (SV == 0 && w < 4 && fq == 0) { const size_t si = (size_t)((l * 4 + pbq) * 64 + g) * 64 + p; F.out[O_PRE + si] = cr_; F.out[O_PIM + si] = ci_; }
    __syncthreads();
    if (SV == 0 && F.tid < 256) { const int rp_ = S5_ROW0(17) + (F.tid >> 1); *(v4u*)(YG + (size_t)rp_ * 1024 + 16 * g + 8 * (F.tid & 1)) = *(const LAS v4u*)(YS + 2048 + (F.tid >> 1) * 16 + 8 * (F.tid & 1)); }
    __syncthreads();
}

__device__ __forceinline__ void s5_phase(const Frame& F, int l) { s5_phase_roles(F, l); }
constexpr int B1S = 132;
__device__ __forceinline__ void b1_phase(const Frame& F, int l) {
    LAS float* MAIN = (LAS float*)F.lds;
    LAS float* XB = MAIN + 64 * B1S;
    LAS float* BT = XB + 64 * B1S;
    LAS float* HALO = BT + 64 * B1S;
    LAS float* SEGP = HALO + 8 * 3 * 128;
    LAS float* SEGH = SEGP + 512;
    LAS bf16* XA = (LAS bf16*)(SEGH + 512);
    static_assert(3 * 64 * B1S * 4 + 8 * 3 * 128 * 4 + 2 * 512 * 4 + 64 * 136 * 2 <= LDSCTL_OFF, "B1 LDS");
    const int tid = F.tid, lane = F.lane, w = F.wave, fr = lane & 15, fq = lane >> 4;
    const bf16* PROJ = (const bf16*)(F.ws + WS_PROJ); unsigned* HP = (unsigned*)(F.ws + WS_HLOC);
    float* SUMA = (float*)(F.ws + WS_SUMA); float* SUMH = (float*)(F.ws + WS_SUMH);
    const float* SCB = inptr(F, I_SCB);
    v4u nm0, nm1, nh; f32x4 ns0, ns1;
    nm0 = nm1 = nh = (v4u){0u, 0u, 0u, 0u}; ns0 = ns1 = (f32x4){0.f, 0.f, 0.f, 0.f};
#define B1_ISSUE(tt) do { const int c_ = (tt) >> 4, hd_ = (tt) & 15, row0_ = c_ * 64, ch0_ = hd_ * 128; const int cs_ = c_ >= 128 ? c_ - 128 : 0;     \
        nm0 = *(const v4u*)(PROJ + (size_t)(row0_ + (tid >> 4)) * INC + OFF_BX + ch0_ + 8 * (tid & 15)); \
        nm1 = *(const v4u*)(PROJ + (size_t)(row0_ + 32 + (tid >> 4)) * INC + OFF_BX + ch0_ + 8 * (tid & 15)); \
        { const int hr_ = row0_ >= 3 ? row0_ - 3 + ((tid >> 4) < 3 ? (tid >> 4) : 0) : 0; nh = *(const v4u*)(PROJ + (size_t)hr_ * INC + OFF_BX + ch0_ + 8 * (tid & 15)); } \
        { const int sq = tid / 96, rem = tid % 96, j = rem >> 5, c4 = rem & 31; ns0 = *(const f32x4*)(SCB + (size_t)((l * 128 + 8 * cs_ + sq) * 3 + j) * 2048 + ch0_ + 4 * c4); } \
        { const int idx = (tid < 256 ? tid : 255) + 512; const int sq = idx / 96, rem = idx % 96, j = rem >> 5, c4 = rem & 31; ns1 = *(const f32x4*)(SCB + (size_t)((l * 128 + 8 * cs_ + sq) * 3 + j) * 2048 + ch0_ + 4 * c4); } } while (0)
    if ((int)blockIdx.x < 2304) B1_ISSUE((int)blockIdx.x);
    float w0 = 0.f, w1 = 0.f, w2 = 0.f, w3 = 0.f, bias = 0.f; f32x4 brg4 = (f32x4){0.f, 0.f, 0.f, 0.f}, big4 = brg4, sp84 = brg4; bf16x8 BR[4], BI[4]; int hdc = -1;
#define B1_LOADW(hd_) do { const int chx = (hd_) * 128 + (tid & 127); const float* wc_ = inptr(F, I_WCB) + (size_t)l * 4 * 2048 + chx; w0 = wc_[0]; w1 = wc_[2048]; w2 = wc_[4096]; w3 = wc_[6144]; bias = inptr(F, I_BCB)[l * 2048 + chx]; \
        const bf16* WR = (const bf16*)(F.ws + WS_WRGT) + (size_t)((l * 16 + (hd_)) * 128 + 16 * w + fr) * 128 + 8 * fq; const bf16* WI = (const bf16*)(F.ws + WS_WIGT) + (size_t)((l * 16 + (hd_)) * 128 + 16 * w + fr) * 128 + 8 * fq; \
        _Pragma("unroll") for (int kk = 0; kk < 4; ++kk) { BR[kk] = *(const bf16x8*)(WR + 32 * kk); BI[kk] = *(const bf16x8*)(WI + 32 * kk); } \
        brg4 = *(const f32x4*)(inptr(F, I_BRG) + (l * 16 + (hd_)) * 128 + 16 * w + 4 * fq); big4 = *(const f32x4*)(inptr(F, I_BIG) + (l * 16 + (hd_)) * 128 + 16 * w + 4 * fq); \
        { const f32x4 lm_ = *(const f32x4*)(inptr(F, I_LAM) + l * 2048 + (hd_) * 128 + 16 * w + 4 * fq); \
          _Pragma("unroll") for (int e_ = 0; e_ < 4; ++e_) sp84[e_] = -8.0f * 1.4426950408889634f * log1pf(__expf(-lm_[e_])); } } while (0)
    for (int ti = blockIdx.x; ti < 2304; ti += F.G) {
        const int c = ti >> 4, hd = ti & 15; const bool smp = c >= 128; const int row0 = c * 64, ch0 = hd * 128;
        if (hd != hdc) { B1_LOADW(hd); hdc = hd; }
        { float f[8]; const int r = tid >> 4, c8 = tid & 15;
          UNPK8(nm0, f); *(LAS f32x4*)(MAIN + r * B1S + 8 * c8) = (f32x4){f[0], f[1], f[2], f[3]}; *(LAS f32x4*)(MAIN + r * B1S + 8 * c8 + 4) = (f32x4){f[4], f[5], f[6], f[7]};
          UNPK8(nm1, f); *(LAS f32x4*)(MAIN + (r + 32) * B1S + 8 * c8) = (f32x4){f[0], f[1], f[2], f[3]}; *(LAS f32x4*)(MAIN + (r + 32) * B1S + 8 * c8 + 4) = (f32x4){f[4], f[5], f[6], f[7]};
          if (!smp) { if (tid < 48) { if ((c & 31) == 0) nh = (v4u){0u, 0u, 0u, 0u}; UNPK8(nh, f); *(LAS f32x4*)(HALO + r * 128 + 8 * c8) = (f32x4){f[0], f[1], f[2], f[3]}; *(LAS f32x4*)(HALO + r * 128 + 8 * c8 + 4) = (f32x4){f[4], f[5], f[6], f[7]}; } }
          else { { const int sq = tid / 96, rem = tid % 96, j = rem >> 5, c4 = rem & 31; *(LAS f32x4*)(HALO + (sq * 3 + j) * 128 + 4 * c4) = ns0; }
                 if (tid < 256) { const int idx = tid + 512; const int sq = idx / 96, rem = idx % 96, j = rem >> 5, c4 = rem & 31; *(LAS f32x4*)(HALO + (sq * 3 + j) * 128 + 4 * c4) = ns1; } } }
        __syncthreads();
        B1_ISSUE(ti + F.G < 2304 ? ti + F.G : ti);
        const int ch = tid & 127, sg = tid >> 7;
        {
            float x1, x2, x3;
            { const int r = 16 * sg; if (smp || r == 0) { const int hb_ = smp ? (r >> 3) * 3 : 0; x3 = HALO[hb_ * 128 + ch]; x2 = HALO[(hb_ + 1) * 128 + ch]; x1 = HALO[(hb_ + 2) * 128 + ch]; }
              else { x3 = MAIN[(r - 3) * B1S + ch]; x2 = MAIN[(r - 2) * B1S + ch]; x1 = MAIN[(r - 1) * B1S + ch]; } }
#pragma unroll
            for (int rr = 0; rr < 16; ++rr) { const int r = 16 * sg + rr;
                if (smp && rr == 8) { const int hb_ = (r >> 3) * 3; x3 = HALO[hb_ * 128 + ch]; x2 = HALO[(hb_ + 1) * 128 + ch]; x1 = HALO[(hb_ + 2) * 128 + ch]; }
                const float x0 = MAIN[r * B1S + ch];
                const float xb = bias + w3 * x0 + w2 * x1 + w1 * x2 + w0 * x3;
                XB[r * B1S + ch] = xb; XA[r * 136 + ch] = (bf16)f2bf(xb); x3 = x2; x2 = x1; x1 = x0; }
            if (!smp) { if ((c & 31) == 31 && sg == 3) { const int seq = c >> 5;
#pragma unroll
                    for (int j = 0; j < 3; ++j) F.out[O_PCB + (size_t)((l * 4 + seq) * 3 + j) * 2048 + ch0 + ch] = MAIN[(61 + j) * B1S + ch]; } }
            else {
#pragma unroll
                for (int s2 = 0; s2 < 2; ++s2) { const int sq = 2 * sg + s2, b = 8 * (c - 128) + sq;
#pragma unroll
                    for (int j = 0; j < 3; ++j) F.out[O_SCB + (size_t)((l * 128 + b) * 3 + j) * 2048 + ch0 + ch] = MAIN[(8 * sq + 5 + j) * B1S + ch]; } }
        }
        __syncthreads();
        {
            f32x4 zr[4], zi[4];
#pragma unroll
            for (int mt = 0; mt < 4; ++mt) { zr[mt] = (f32x4){0.f, 0.f, 0.f, 0.f}; zi[mt] = (f32x4){0.f, 0.f, 0.f, 0.f}; }
#pragma unroll
            for (int mt = 0; mt < 4; ++mt)
#pragma unroll
                for (int kk = 0; kk < 4; ++kk) { const bf16x8 ax = *(const LAS bf16x8*)(XA + (16 * mt + fr) * 136 + 32 * kk + 8 * fq);
                    zr[mt] = __builtin_amdgcn_mfma_f32_16x16x32_bf16(BR[kk], ax, zr[mt], 0, 0, 0); zi[mt] = __builtin_amdgcn_mfma_f32_16x16x32_bf16(BI[kk], ax, zi[mt], 0, 0, 0); }
            float A_[4][4], H_[4][4];
#pragma unroll
            for (int mt = 0; mt < 4; ++mt) { const f32x4 xv = *(const LAS f32x4*)(XB + (16 * mt + fr) * B1S + 16 * w + 4 * fq);
#pragma unroll
                for (int rg = 0; rg < 4; ++rg) { const float rr_ = sigm(zr[mt][rg] + brg4[rg]), ig = sigm(zi[mt][rg] + big4[rg]);
                    const float av = __builtin_amdgcn_exp2f(sp84[rg] * rr_); const float beta = __builtin_amdgcn_sqrtf(fmaxf(1.0f - av * av, 0.f));
                    A_[mt][rg] = av; H_[mt][rg] = beta * ig * xv[rg]; } }
#define B1_SHR(x, d, ident) __builtin_bit_cast(float, __builtin_amdgcn_update_dpp(__builtin_bit_cast(int, (float)(ident)), __builtin_bit_cast(int, (float)(x)), 0x110 + (d), 0xf, 0xf, false))
#define B1_SCAN_STEP(d, seg) do { _Pragma("unroll") for (int mt = 0; mt < 4; ++mt) _Pragma("unroll") for (int rg = 0; rg < 4; ++rg) { \
                float as_ = B1_SHR(A_[mt][rg], d, 1.0f), hs_ = B1_SHR(H_[mt][rg], d, 0.0f); if ((seg) && (fr & 7) < (d)) { as_ = 1.0f; hs_ = 0.0f; } \
                H_[mt][rg] = A_[mt][rg] * hs_ + H_[mt][rg]; A_[mt][rg] *= as_; } } while (0)
            if (!smp) {
#define B1_DPP_STEP(d) do { _Pragma("unroll") for (int mt = 0; mt < 4; ++mt) _Pragma("unroll") for (int rg = 0; rg < 4; ++rg) \
                    asm volatile("s_nop 1\n\tv_fmac_f32_dpp %0, %0, %1 row_shr:" #d " row_mask:0xf bank_mask:0xf\n\tv_mul_f32_dpp %1, %1, %1 row_shr:" #d " row_mask:0xf bank_mask:0xf" : "+v"(H_[mt][rg]), "+v"(A_[mt][rg])); } while (0)
                B1_DPP_STEP(1); B1_DPP_STEP(2); B1_DPP_STEP(4); B1_DPP_STEP(8);
#undef B1_DPP_STEP
                float cP[4], cH[4];
#pragma unroll
                for (int mt = 0; mt < 4; ++mt)
#pragma unroll
                    for (int rg = 0; rg < 4; ++rg) { if (mt > 0) { H_[mt][rg] = H_[mt][rg] + A_[mt][rg] * cH[rg]; A_[mt][rg] *= cP[rg]; }
                        cH[rg] = __shfl(H_[mt][rg], (lane & 48) | 15); cP[rg] = __shfl(A_[mt][rg], (lane & 48) | 15); }
                if (fr == 15) { *(f32x4*)(SUMA + (size_t)c * 2048 + ch0 + 16 * w + 4 * fq) = (f32x4){A_[3][0], A_[3][1], A_[3][2], A_[3][3]};
                                *(f32x4*)(SUMH + (size_t)c * 2048 + ch0 + 16 * w + 4 * fq) = (f32x4){H_[3][0], H_[3][1], H_[3][2], H_[3][3]}; }
            } else { B1_SCAN_STEP(1, true); B1_SCAN_STEP(2, true); B1_SCAN_STEP(4, true); }
#undef B1_SCAN_STEP
#undef B1_SHR
#pragma unroll
            for (int mt = 0; mt < 4; ++mt) { v4u o; o.x = pk2(H_[mt][0], A_[mt][0]); o.y = pk2(H_[mt][1], A_[mt][1]); o.z = pk2(H_[mt][2], A_[mt][2]); o.w = pk2(H_[mt][3], A_[mt][3]);
                *(v4u*)(HP + (size_t)(row0 + 16 * mt + fr) * 2048 + ch0 + 16 * w + 4 * fq) = o; }
        }
    }
    __syncthreads();
}

__device__ __forceinline__ void mixa_item(const Frame& F, int l, int item) {
    const bf16* PROJ = (const bf16*)(F.ws + WS_PROJ); bf16* MIX = (bf16*)(F.ws + WS_MIX);
    {
        const int c8 = item >> 7, strip = item & 127, r0 = 8 * c8, ch = 8 * strip; const bool smp = r0 >= NPROMPT; const int t0 = smp ? 0 : (r0 & 2047);
        float w0[8], w1[8], w2[8], bs[8], p2[8], p1[8];
        { const float* wa = inptr(F, I_WCA) + (size_t)l * 3 * 1024 + ch; const float* ba = inptr(F, I_BCA) + l * 1024 + ch;
#pragma unroll
          for (int h = 0; h < 2; ++h) { const f32x4 a = *(const f32x4*)(wa + 4 * h), b = *(const f32x4*)(wa + 1024 + 4 * h), cc = *(const f32x4*)(wa + 2048 + 4 * h), d = *(const f32x4*)(ba + 4 * h);
#pragma unroll
              for (int e = 0; e < 4; ++e) { w0[4 * h + e] = a[e]; w1[4 * h + e] = b[e]; w2[4 * h + e] = cc[e]; bs[4 * h + e] = d[e]; } } }
        if (t0 >= 2) {
            const v4u c2 = *(const v4u*)(PROJ + (size_t)(r0 - 2) * INC + OFF_CIN + ch), c1 = *(const v4u*)(PROJ + (size_t)(r0 - 1) * INC + OFF_CIN + ch);
            UNPK8(c2, p2); UNPK8(c1, p1);
        } else if (!smp) {
#pragma unroll
            for (int e = 0; e < 8; ++e) { p2[e] = 0.f; p1[e] = 0.f; }
        } else { const int b = (r0 - NPROMPT) >> 3; const float* st = inptr(F, I_SCA) + (size_t)((l * 128 + b) * 2) * 1024 + ch;
#pragma unroll
            for (int h = 0; h < 2; ++h) { const f32x4 a = *(const f32x4*)(st + 4 * h), bb = *(const f32x4*)(st + 1024 + 4 * h);
#pragma unroll
                for (int e = 0; e < 4; ++e) { p2[4 * h + e] = a[e]; p1[4 * h + e] = bb[e]; } } }
        v4u vc[8], vp[8];
#pragma unroll
        for (int r = 0; r < 8; ++r) { const bf16* pr = PROJ + (size_t)(r0 + r) * INC + ch; vc[r] = *(const v4u*)(pr + OFF_CIN); vp[r] = *(const v4u*)(pr + OFF_PG); }
        __builtin_amdgcn_sched_barrier(0);
#pragma unroll
        for (int r = 0; r < 8; ++r) { float cin[8], pg[8], o[8]; UNPK8(vc[r], cin); UNPK8(vp[r], pg);
#pragma unroll
            for (int e = 0; e < 8; ++e) { const float cv = bs[e] + w0[e] * p2[e] + w1[e] * p1[e] + w2[e] * cin[e]; o[e] = pg[e] * cv; p2[e] = p1[e]; p1[e] = cin[e]; }
            v4u wv; wv.x = pk2(o[0], o[1]); wv.y = pk2(o[2], o[3]); wv.z = pk2(o[4], o[5]); wv.w = pk2(o[6], o[7]); *(v4u*)(MIX + (size_t)(r0 + r) * DM + ch) = wv; }
        if (smp || t0 == 2040) { const int sq = seq_of_row(r0); float* so = F.out + (sq < 4 ? O_PCA + (size_t)((l * 4 + sq) * 2) * 1024 : O_SCA + (size_t)((l * 128 + sq - 4) * 2) * 1024) + ch;
            *(f32x4*)(so) = (f32x4){p2[0], p2[1], p2[2], p2[3]}; *(f32x4*)(so + 4) = (f32x4){p2[4], p2[5], p2[6], p2[7]};
            *(f32x4*)(so + 1024) = (f32x4){p1[0], p1[1], p1[2], p1[3]}; *(f32x4*)(so + 1028) = (f32x4){p1[4], p1[5], p1[6], p1[7]}; }
    }
}

constexpr int CW_B2CNT = 8192;
__device__ __forceinline__ void b2_phase(const Frame& F, int l) {
    const bf16* PROJ = (const bf16*)(F.ws + WS_PROJ); bf16* MIX = (bf16*)(F.ws + WS_MIX);
    const unsigned* HP = (const unsigned*)(F.ws + WS_HLOC);
    const float* SUMA = (const float*)(F.ws + WS_SUMA); const float* SUMH = (const float*)(F.ws + WS_SUMH);
    const float* SLH = inptr(F, I_SLH);
    gu32* ctr = F.ctl + CW_B2CNT + 64 * l;
    bool first = (int)blockIdx.x >= 144;
    for (;;) {
        int blk;
        if (first) { blk = (int)blockIdx.x - 144; first = false; }
        else {
            if (F.tid == 0) F.MISC[0] = __hip_atomic_fetch_add(ctr, 1u, RLX_AGENT) + 112u;
            __syncthreads();
            blk = (int)F.MISC[0];
            __syncthreads(); }
        if (blk >= 288 + 288) break;
        if (blk >= 288) { mixa_item(F, l, (blk - 288) * 512 + F.tid); continue; }
        const int item = blk * 512 + F.tid;
        const int c = item >> 10, rq = (item >> 8) & 3, ch = 8 * (item & 255); const bool smp = c >= 128;
        float hin[8];
#pragma unroll
        for (int e = 0; e < 8; ++e) hin[e] = 0.f;
        if (!smp) { const int cc = c & 31; const float* sa = SUMA + (size_t)(c - cc) * 2048 + ch; const float* sh = SUMH + (size_t)(c - cc) * 2048 + ch;
            int k = 0;
            for (; k + 4 <= cc; k += 4) { f32x4 a0[4], a1[4], h0[4], h1[4];
#pragma unroll
                for (int u = 0; u < 4; ++u) { a0[u] = *(const f32x4*)(sa + (size_t)(k + u) * 2048); a1[u] = *(const f32x4*)(sa + (size_t)(k + u) * 2048 + 4); h0[u] = *(const f32x4*)(sh + (size_t)(k + u) * 2048); h1[u] = *(const f32x4*)(sh + (size_t)(k + u) * 2048 + 4); }
#pragma unroll
                for (int u = 0; u < 4; ++u)
#pragma unroll
                    for (int e = 0; e < 4; ++e) { hin[e] = a0[u][e] * hin[e] + h0[u][e]; hin[4 + e] = a1[u][e] * hin[4 + e] + h1[u][e]; } }
            for (; k < cc; ++k) { const f32x4 a0 = *(const f32x4*)(sa + (size_t)k * 2048), a1 = *(const f32x4*)(sa + (size_t)k * 2048 + 4), h0 = *(const f32x4*)(sh + (size_t)k * 2048), h1 = *(const f32x4*)(sh + (size_t)k * 2048 + 4);
#pragma unroll
                for (int e = 0; e < 4; ++e) { hin[e] = a0[e] * hin[e] + h0[e]; hin[4 + e] = a1[e] * hin[4 + e] + h1[e]; } } }
        v4u hp0[2][4], hp1[2][4], vg[2][4];
#define B2_LOAD(s_, rb_) do { _Pragma("unroll") for (int u = 0; u < 4; ++u) { const int row = c * 64 + 16 * rq + 4 * (rb_) + u; const size_t o = (size_t)row * 2048 + ch; \
            hp0[s_][u] = *(const v4u*)(HP + o); hp1[s_][u] = *(const v4u*)(HP + o + 4); vg[s_][u] = *(const v4u*)(PROJ + (size_t)row * INC + OFF_BG + ch); } } while (0)
#define B2_COMBINE(s_, rb_) do { _Pragma("unroll") for (int u = 0; u < 4; ++u) { const int r = 16 * rq + 4 * (rb_) + u, row = c * 64 + r; float bg[8], hv[8], ov[8]; UNPK8(vg[s_][u], bg); \
            hv[0] = bflo(hp0[s_][u].x) + bfhi(hp0[s_][u].x) * hin[0]; hv[1] = bflo(hp0[s_][u].y) + bfhi(hp0[s_][u].y) * hin[1]; hv[2] = bflo(hp0[s_][u].z) + bfhi(hp0[s_][u].z) * hin[2]; hv[3] = bflo(hp0[s_][u].w) + bfhi(hp0[s_][u].w) * hin[3]; \
            hv[4] = bflo(hp1[s_][u].x) + bfhi(hp1[s_][u].x) * hin[4]; hv[5] = bflo(hp1[s_][u].y) + bfhi(hp1[s_][u].y) * hin[5]; hv[6] = bflo(hp1[s_][u].z) + bfhi(hp1[s_][u].z) * hin[6]; hv[7] = bflo(hp1[s_][u].w) + bfhi(hp1[s_][u].w) * hin[7]; \
            _Pragma("unroll") for (int e = 0; e < 8; ++e) ov[e] = hv[e] * silu(bg[e]); \
            v4u wv; wv.x = pk2(ov[0], ov[1]); wv.y = pk2(ov[2], ov[3]); wv.z = pk2(ov[4], ov[5]); wv.w = pk2(ov[6], ov[7]); *(v4u*)(MIX + (size_t)row * DM + 1024 + ch) = wv; \
            bool last; float* so; \
            if (smp) { last = (r & 7) == 7; so = F.out + O_SH + (size_t)(l * 128 + 8 * (c - 128) + (r >> 3)) * 2048 + ch; } \
            else { last = ((c & 31) == 31) && r == 63; so = F.out + O_PH + (size_t)(l * 4 + (c >> 5)) * 2048 + ch; } \
            if (last) { *(f32x4*)so = (f32x4){hv[0], hv[1], hv[2], hv[3]}; *(f32x4*)(so + 4) = (f32x4){hv[4], hv[5], hv[6], hv[7]}; } } } while (0)
#define B2_STATE(rb_) do { if (smp && ((rb_) & 1) == 0) { const int b = 8 * (c - 128) + ((16 * rq + 4 * (rb_)) >> 3); const float* st = SLH + (size_t)(l * 128 + b) * 2048 + ch; const f32x4 s0 = *(const f32x4*)st, s1 = *(const f32x4*)(st + 4); \
            _Pragma("unroll") for (int e = 0; e < 4; ++e) { hin[e] = s0[e]; hin[4 + e] = s1[e]; } } } while (0)
        B2_LOAD(0, 0);
        B2_STATE(0); B2_LOAD(1, 1); __builtin_amdgcn_sched_barrier(0); B2_COMBINE(0, 0);
        B2_STATE(1); B2_LOAD(0, 2); __builtin_amdgcn_sched_barrier(0); B2_COMBINE(1, 1);
        B2_STATE(2); B2_LOAD(1, 3); __builtin_amdgcn_sched_barrier(0); B2_COMBINE(0, 2);
        B2_STATE(3); B2_COMBINE(1, 3);
#undef B2_LOAD
#undef B2_COMBINE
#undef B2_STATE
    }
}


__device__ __forceinline__ void stream_probe(const Frame& F, int mode) {
    const float* W = inptr(F, I_WADA); const int tid = F.tid; const int b = blockIdx.x;
    f32x4 acc = (f32x4){0.f, 0.f, 0.f, 0.f}; f32x4 va[8], vb[8];
    size_t base; unsigned step;
    if (mode == 0) { base = (size_t)b * 393216 + 4 * tid; step = 2048; }
    else if (mode == 1) { const int l = b >> 7, r = b & 127, nb = r & 31, kc = r >> 5; const int row = tid / 96, c = tid % 96;
        base = (size_t)l * 4096 * MODW + (size_t)(kc * 1024 + (row < 5 ? row : 4)) * MODW + nb * 384 + 4 * c; step = 5 * MODW; }
    else { const int l = b >> 7, cb = b & 127; const int row = tid / 24, c = tid % 24;
        base = (size_t)l * 4096 * MODW + (size_t)(row < 21 ? row : 20) * MODW + cb * 96 + 4 * c; step = 21 * MODW; }
    const int nload = mode == 0 ? 192 : (mode == 1 ? 200 : 192);
    const float* p = W + base;
#define SP_LOAD(v, i0) do { _Pragma("unroll") for (int j = 0; j < 8; ++j) { const int ii = (i0) + j < nload ? (i0) + j : nload - 1; v[j] = __builtin_nontemporal_load((const f32x4*)(p + (size_t)ii * step)); } } while (0)
#define SP_SUM(v) do { _Pragma("unroll") for (int j = 0; j < 8; ++j) acc += v[j]; } while (0)
    SP_LOAD(va, 0);
    for (int i = 0; i < nload; i += 16) { SP_LOAD(vb, i + 8); SP_SUM(va); SP_LOAD(va, i + 16); SP_SUM(vb); }
#undef SP_LOAD
#undef SP_SUM
    if (acc.x + acc.y + acc.z + acc.w == 123.456789f) F.out[0] = 1.0f;
}
#define PHASE_FRAME() Frame Fp = F; Fp.ws = launder(F.ws); Fp.out = launder(F.out);
__device__ __forceinline__ void run_pre(const Frame& F) { PHASE_FRAME()
    const float* cp = inptr(Fp, I_CP); const float* cs = inptr(Fp, I_CS); bf16* CB = (bf16*)(Fp.ws + WS_CBF);
    for (int i = blockIdx.x * 512 + Fp.tid; i < 144 * 1024; i += Fp.G * 512) { const int row = i >> 10, c4 = (i & 1023) * 4;
        f32x4 v = (f32x4){0.f, 0.f, 0.f, 0.f}; if (row < NSEQ) v = *(const f32x4*)((row < 4 ? cp + (size_t)row * 4096 : cs + (size_t)(row - 4) * 4096) + c4);
        u32x2 o; o.x = pk2(v.x, v.y); o.y = pk2(v.z, v.w); *(u32x2*)(CB + (size_t)(c4 >> 6) * 9216 + row * 64 + (c4 & 63)) = o; }
}
__device__ __forceinline__ void run_p0(const Frame& F) { PHASE_FRAME()
    if (F.G == 256) { adaln_task(Fp, (int)blockIdx.x >> 7, (int)blockIdx.x & 127); if (PROBE_DUP & 64) { adaln_task_t<PROBE_ADA>(Fp, (int)blockIdx.x >> 7, (int)blockIdx.x & 127); adaln_task_t<PROBE_ADA>(Fp, (int)blockIdx.x >> 7, (int)blockIdx.x & 127); adaln_task_t<PROBE_ADA>(Fp, (int)blockIdx.x >> 7, (int)blockIdx.x & 127); } }
    else for (int t = blockIdx.x; t < 256; t += F.G) adaln_task(Fp, t >> 7, t & 127);
    __syncthreads();
    if (PROBE_DUP & 16384) { stream_probe(Fp, 0); stream_probe(Fp, 0); stream_probe(Fp, 0); } if (PROBE_DUP & 32768) { stream_probe(Fp, 1); stream_probe(Fp, 1); stream_probe(Fp, 1); } if (PROBE_DUP & 65536) { stream_probe(Fp, 2); stream_probe(Fp, 2); stream_probe(Fp, 2); }
    tr_run(Fp, 0, 5, blockIdx.x * NWAVES + Fp.wave, Fp.G * NWAVES);
    tr_run(Fp, 1, 4, blockIdx.x * NWAVES + Fp.wave, Fp.G * NWAVES);
    if (PROBE_DUP & 128) { __syncthreads(); tr_run(Fp, 0, 5, blockIdx.x * NWAVES + Fp.wave, Fp.G * NWAVES); __syncthreads(); tr_run(Fp, 0, 5, blockIdx.x * NWAVES + Fp.wave, Fp.G * NWAVES); __syncthreads(); tr_run(Fp, 0, 5, blockIdx.x * NWAVES + Fp.wave, Fp.G * NWAVES); }
    __syncthreads();
    if ((int)blockIdx.x >= 192) s5_mats(Fp, 0, (int)blockIdx.x - 192);
}
__device__ __forceinline__ void run_norm0(const Frame& F) { PHASE_FRAME() norm_phase<false, false>(Fp, inptr(Fp, I_XP), inptr(Fp, I_XS), 0, 0, nullptr, nullptr, nullptr, 4); }
template <int l> __device__ __forceinline__ void run_gemm1(const Frame& F) { PHASE_FRAME()
    const bool side = (F.G == 256);
    if (!side || (int)blockIdx.x < 240) {
        pg8::Gemm g{(const bf16*)(Fp.ws + WS_HP), (const bf16*)(Fp.ws + WS_WINTP) + (size_t)l * 10240 * LDK, MROWS, INC, LDK}; pg8::StaticOrder S; S.init(MROWS, INC, side ? 240 : F.G, (int)blockIdx.x, DM);
        EpiProj E{(bf16*)(Fp.ws + WS_PROJ)};
        pg8::gemm_phase<EpiProj, pg8::StaticOrder, GEMM1_ALIGN, GEMM1_SP2>(F.lds + RING_OFF, g, S, E);
        if (!side) { tr_run(Fp, l, 2, blockIdx.x * NWAVES + Fp.wave, Fp.G * NWAVES); if (l == 0) tr_run(Fp, 1, 1, blockIdx.x * NWAVES + Fp.wave, Fp.G * NWAVES); }
    } else {
        const int widx = ((int)blockIdx.x - 240) * NWAVES + Fp.wave;
        tr_run(Fp, l, 2, widx, 16 * NWAVES);
        if (l == 0) tr_run(Fp, 1, 1, widx, 16 * NWAVES);
        if (PROBE_DUP & 4096) { __syncthreads(); tr_run(Fp, l, 2, widx, 16 * NWAVES); if (l == 0) tr_run(Fp, 1, 1, widx, 16 * NWAVES); }
        __syncthreads();
        if (l == 1) for (int g = (int)blockIdx.x - 240; g < 64; g += 16) s5_mats(Fp, 1, g);
    }
    __syncthreads();
}
template <int l> __device__ __forceinline__ void run_mix1(const Frame& F) { PHASE_FRAME() s5_phase(Fp, l); if (PROBE_DUP & 256) { s5_phase(Fp, l); s5_phase(Fp, l); s5_phase(Fp, l); } b1_phase(Fp, l); if (PROBE_DUP & 512) b1_phase(Fp, l); }
template <int l> __device__ __forceinline__ void run_mix2(const Frame& F) { PHASE_FRAME()
    if ((int)blockIdx.x < 144) {
        pg8::Gemm g{(const bf16*)(Fp.ws + WS_YG), (const bf16*)(Fp.ws + WS_WGLUT) + (size_t)l * 1024 * 1024, MROWS, 1024, 1024}; pg8::StaticOrder S; S.init(MROWS, 1024, 144, (int)blockIdx.x, 1024);
        EpiGlu E{(const bf16*)(Fp.ws + WS_YG), (const bf16*)(Fp.ws + WS_PROJ), inptr(Fp, I_BGLU) + l * 1024, (bf16*)(Fp.ws + WS_MIX)};
        pg8::gemm_phase<EpiGlu, pg8::StaticOrder, true, true>(F.lds + RING_OFF, g, S, E);
    }
    b2_phase(Fp, l);
}
template <int l> __device__ __forceinline__ void run_gemm2(const Frame& F) { PHASE_FRAME()
    bf16* X1 = (bf16*)(Fp.ws + WS_X1); const float* MOD = (const float*)(Fp.ws + WS_MOD);
    pg8::Gemm g{(const bf16*)(Fp.ws + WS_MIX), (const bf16*)(Fp.ws + WS_WOUTT) + (size_t)l * 4096 * 4096, MROWS, DM, DM}; Gemm2Order S; S.init(F.G, (int)blockIdx.x);
    if (l == 0) { EpiResGate<false> E{inptr(Fp, I_XP), inptr(Fp, I_XS), X1, MOD + 2 * DM, (bf16*)(Fp.ws + WS_PCUM)};
        pg8::gemm_phase<EpiResGate<false>, Gemm2Order, true, true>(F.lds + RING_OFF, g, S, E); }
    else { EpiResGate<true> E{X1, X1 + (size_t)NPROMPT * DM, (bf16*)(Fp.ws + WS_H), MOD + (size_t)NSEQ * MODW + 2 * DM, (bf16*)(Fp.ws + WS_PCUM)};
        pg8::gemm_phase<EpiResGate<true>, Gemm2Order, true, true>(F.lds + RING_OFF, g, S, E); }
}
template <int l> __device__ __forceinline__ void run_norm(const Frame& F) { PHASE_FRAME() bf16* X1 = (bf16*)(Fp.ws + WS_X1);
    const bf16* part = (const bf16*)(Fp.ws + WS_PCUM); const float* gate = (const float*)(Fp.ws + WS_MOD) + (size_t)l * NSEQ * MODW + 2 * DM;
    if (l == 0) norm_phase<true, false>(Fp, X1, inptr(Fp, I_XS), 0, 1, part, gate, X1 + (size_t)NPROMPT * DM, 2);
    else norm_phase<true, true>(Fp, Fp.ws + WS_H, X1 + (size_t)NPROMPT * DM, 1, 0, part, gate, nullptr, 3); }
#define DUP(bit, call) do { call; if ((PROBE_DUP >> (bit)) & 1) { call; } } while (0)
template <int l> __device__ __forceinline__ void layer_program(const Frame& F, const XcdBarrier& bar, int lo, int hi) {
#define IN(k) (lo <= (k) && (k) < hi)
#define SEAM(k) do { if (IN(k) && IN((k) + 1)) { xcd_barrier(bar); if (PROBE_DUP & 2048) xcd_barrier(bar); } } while (0)
    const int pb = 2 + 5 * l;
    if (IN(pb)) DUP(2, run_gemm1<l>(F));
    SEAM(pb);
    if (IN(pb + 1)) DUP(3, run_mix1<l>(F));
    SEAM(pb + 1);
    if (IN(pb + 2)) DUP(4, run_mix2<l>(F));
    SEAM(pb + 2);
    if (IN(pb + 3)) { run_gemm2<l>(F); if ((PROBE_DUP >> 5) & 1) { run_gemm2<l>(F); run_gemm2<l>(F); run_gemm2<l>(F); } }
    SEAM(pb + 3);
    if (IN(pb + 4)) { run_norm<l>(F); if (l == 0 && ((PROBE_DUP >> 1) & 1)) run_norm<l>(F); }
    SEAM(pb + 4);
#undef IN
#undef SEAM
}
struct Args { const float* in[34]; float* out; unsigned char* ws; int ph_lo, ph_hi; };
__global__ void __launch_bounds__(NWAVES * 64, 2) mega_fwd(Args args) {
    extern __shared__ __attribute__((aligned(16))) unsigned char lds[];
    Frame F;
    F.lds = (LAS unsigned char*)lds; F.MISC = (volatile LAS unsigned*)(F.lds + MISC_OFF);
    F.tid = threadIdx.x; F.lane = F.tid & 63; F.wave = __builtin_amdgcn_readfirstlane(F.tid >> 6); F.G = gridDim.x;
    F.out = args.out; F.ws = args.ws; F.ctl = (gu32*)(args.ws + WS_CTL);
    if (F.tid < 128) ((LAS unsigned*)(F.lds + LDSCTL_OFF))[F.tid] = 0u;
    if (F.tid >= 128 && F.tid < 128 + 34) { const __attribute__((address_space(4))) unsigned long long* ka = (const __attribute__((address_space(4))) unsigned long long*)__builtin_amdgcn_kernarg_segment_ptr();
        ((LAS unsigned long long*)(F.lds + PTR_OFF))[F.tid - 128] = ka[F.tid - 128]; }
    __syncthreads();
    XcdBarrier bar; bar.bar = (unsigned*)(F.ctl + CW_BAR); bar.x = 0; bar.st = nullptr;
    if (N_LAUNCHES == 1) bar = xcd_barrier_post((unsigned*)(F.ctl + CW_BAR), F.MISC + 8);
    const int lo = args.ph_lo, hi = args.ph_hi;
#define IN(k) (lo <= (k) && (k) < hi)
#define SEAM(k) do { if (IN(k) && IN((k) + 1)) { xcd_barrier(bar); if (PROBE_DUP & 2048) xcd_barrier(bar); } } while (0)
    if (IN(0)) { run_pre(F); if (N_LAUNCHES == 1) xcd_barrier(bar); run_p0(F); if (PROBE_DUP & 1) { run_p0(F); run_p0(F); run_p0(F); } }
    SEAM(0);
    if (IN(1)) DUP(1, run_norm0(F));
    SEAM(1);
    layer_program<0>(F, bar, lo, hi);
    layer_program<1>(F, bar, lo, hi);
#undef IN
#undef SEAM
}

extern "C" void kernel_launch(void* const* d_in, const int* in_sizes, int n_in, void* d_out, int out_size, void* d_ws, size_t ws_size, hipStream_t stream) {
    static int grid = 0;
    if (grid == 0) {
        if (n_in != 34 || out_size != (int)O_END || ws_size < WS_END) { fprintf(stderr, "kernel_launch: unexpected shapes: n_in %d out %d ws %zu\n", n_in, out_size, ws_size); grid = -1; return; }
        int dev = 0, cus = 0, per_cu = 0;
        if (hipGetDevice(&dev) != hipSuccess || hipDeviceGetAttribute(&cus, hipDeviceAttributeMultiprocessorCount, dev) != hipSuccess) { grid = -1; return; }
        if (hipFuncSetAttribute((const void*)mega_fwd, hipFuncAttributeMaxDynamicSharedMemorySize, LDS_BYTES) != hipSuccess) { fprintf(stderr, "kernel_launch: hipFuncSetAttribute failed\n"); grid = -1; return; }
        if (hipOccupancyMaxActiveBlocksPerMultiprocessor(&per_cu, (const void*)mega_fwd, NWAVES * 64, LDS_BYTES) != hipSuccess || per_cu < 1)
            fprintf(stderr, "kernel_launch: occupancy query reports %d workgroups per CU\n", per_cu);
        (void)hipGetLastError();
        if (cus < 256) { fprintf(stderr, "kernel_launch: this kernel needs 256 CUs (one persistent workgroup each); found %d\n", cus); grid = -1; return; }
        grid = 256;
    }
    if (grid < 0) return;
    if (hipMemsetAsync((char*)d_ws + WS_CTL, 0, CTL_ZERO_BYTES, stream) != hipSuccess) { fprintf(stderr, "kernel_launch: memset failed\n"); return; }
    Args a{};
    for (int i = 0; i < 34; ++i) a.in[i] = (const float*)d_in[i];
    a.out = (float*)d_out; a.ws = (unsigned char*)d_ws;
    if (N_LAUNCHES == 1) { a.ph_lo = 0; a.ph_hi = N_PHASES; hipLaunchKernelGGL(mega_fwd, dim3(grid), dim3(NWAVES * 64), LDS_BYTES, stream, a); }
    else for (int p = 0; p < N_PHASES; ++p) { a.ph_lo = p; a.ph_hi = p + 1; hipLaunchKernelGGL(mega_fwd, dim3(grid), dim3(NWAVES * 64), LDS_BYTES, stream, a); }
    const hipError_t le = hipPeekAtLastError();
    if (le != hipSuccess) fprintf(stderr, "kernel_launch: launch failed: %s\n", hipGetErrorName(le));
}
```
